# Optimizing an MI355X kernel written in HIP

```python
import jax, jax.numpy as jnp
from jax import lax
import numpy as np

D_MODEL = 2048
BATCH = 16
SEQ = 256
DEPTH = 1
DEC_BATCH = 8
DEC_SEQ = 1024
PAST_LEN = 512

GRID_W = 64
N_HEADS = 16
N_KV_HEADS = 4
HEAD_DIM = 128
ROPE_THETA = 10000.0
Q_BLOCK = 128
N_RET_HEADS = 8
RET_KEY_DIM = 128
RET_VAL_DIM = 256
RET_CHUNK = 128
D_FF = ((8 * D_MODEL // 3 + 255) // 256) * 256
EPS = 1e-6

ATTN_Q = N_HEADS * HEAD_DIM
ATTN_KV = N_KV_HEADS * HEAD_DIM
RET_QK = N_RET_HEADS * RET_KEY_DIM
RET_V = N_RET_HEADS * RET_VAL_DIM
IN_SPLITS = (ATTN_Q, ATTN_KV, ATTN_KV, RET_QK, RET_QK, RET_V, RET_V, D_MODEL, D_MODEL)
IN_OFFSETS = tuple(sum(IN_SPLITS[:i + 1]) for i in range(len(IN_SPLITS) - 1))
N_IN = sum(IN_SPLITS)

kernel_name = 'hybrid_gqa_retention_prefix_dit_step'


def rms_norm(x, g):
    xf = x.astype(jnp.float32)
    y = xf * lax.rsqrt(jnp.mean(xf * xf, axis=-1, keepdims=True) + EPS)
    return (y * g.astype(jnp.float32)).astype(x.dtype)


def rope_2d(x):
    L = x.shape[1]
    rows = L // GRID_W
    row = jnp.repeat(jnp.arange(rows, dtype=jnp.float32), GRID_W)
    col = jnp.tile(jnp.arange(GRID_W, dtype=jnp.float32), rows)
    half = HEAD_DIM // 2
    quarter = half // 2
    inv_freq = ROPE_THETA ** (-jnp.arange(quarter, dtype=jnp.float32) / quarter)
    xf = x.astype(jnp.float32)

    def rot(xs, pos):
        ang = pos[:, None] * inv_freq[None, :]
        cos = jnp.cos(ang)[None, :, None, :]
        sin = jnp.sin(ang)[None, :, None, :]
        x1, x2 = xs[..., :quarter], xs[..., quarter:]
        return jnp.concatenate([x1 * cos - x2 * sin, x2 * cos + x1 * sin], axis=-1)

    out = jnp.concatenate([rot(xf[..., :half], row), rot(xf[..., half:], col)], axis=-1)
    return out.astype(x.dtype)


def block_attention(q, k, v):
    b, Lq, _, d = q.shape
    grp = N_HEADS // N_KV_HEADS
    n_blk = Lq // Q_BLOCK
    scale = d ** -0.5
    qb = q.reshape(b, n_blk, Q_BLOCK, N_KV_HEADS, grp, d).transpose(1, 0, 2, 3, 4, 5)

    def one_block(q_blk):
        s = jnp.einsum('bqkgd,bskd->bkgqs', q_blk, k).astype(jnp.float32) * scale
        p = jax.nn.softmax(s, axis=-1)
        return jnp.einsum('bkgqs,bskd->bqkgd', p.astype(v.dtype), v)

    o = lax.map(one_block, qb)
    return o.transpose(1, 0, 2, 3, 4, 5).reshape(b, Lq, N_HEADS * d)


def retention_dir(q, k, v, log_g, s0):
    b, h, L, dk = q.shape
    dv = v.shape[-1]
    n_c = L // RET_CHUNK
    qc = q.reshape(b, h, n_c, RET_CHUNK, dk)
    kc = k.reshape(b, h, n_c, RET_CHUNK, dk)
    vc = v.reshape(b, h, n_c, RET_CHUNK, dv)
    idx = jnp.arange(RET_CHUNK, dtype=jnp.float32)
    diff = idx[:, None] - idx[None, :]
    dmat = jnp.where(diff >= 0, jnp.exp(jnp.maximum(diff, 0.0)[None] * log_g[:, None, None]), 0.0)
    scores = jnp.einsum('bhcid,bhcjd->bhcij', qc, kc) * dmat[None, :, None]
    inner = jnp.einsum('bhcij,bhcje->bhcie', scores, vc)
    zeta = jnp.exp((RET_CHUNK - 1 - idx)[None, :] * log_g[:, None])
    u = jnp.einsum('bhcjd,bhcje->cbhde', kc * zeta[None, :, None, :, None], vc)
    g_chunk = jnp.exp(RET_CHUNK * log_g)[None, :, None, None]

    def step(s, u_c):
        return g_chunk * s + u_c, s

    s_fin, s_prev = lax.scan(step, s0, u)
    xi = jnp.exp((idx + 1.0)[None, :] * log_g[:, None])
    cross = jnp.einsum('bhcid,cbhde->bhcie', qc, s_prev) * xi[None, :, None, :, None]
    return (inner + cross).reshape(b, h, L, dv), s_fin


def bidir_retention(q, k, v, log_g_f, log_g_b, s0_f, s0_b):
    o_f, s_f = retention_dir(q, k, v, log_g_f, s0_f)
    o_b, s_b = retention_dir(jnp.flip(q, 2), jnp.flip(k, 2), jnp.flip(v, 2), log_g_b, s0_b)
    return o_f + jnp.flip(o_b, 2), s_f, s_b


def token_mixer(h, w_in, q_norm, k_norm, dec_f, dec_b, ret_norm, w_ba, w_br, w_out,
                ctx_k, ctx_v, s0_f, s0_b, latent):
    b, L, _ = h.shape
    z = h @ w_in
    q_a, k_a, v_a, q_r, k_r, v_r, g_r, gate_a, gate_r = jnp.split(z, IN_OFFSETS, axis=-1)
    q_a = rms_norm(q_a.reshape(b, L, N_HEADS, HEAD_DIM), q_norm)
    k_a = rms_norm(k_a.reshape(b, L, N_KV_HEADS, HEAD_DIM), k_norm)
    v_a = v_a.reshape(b, L, N_KV_HEADS, HEAD_DIM)
    if latent:
        q_use = rope_2d(q_a)
        k_all = jnp.concatenate([ctx_k.astype(k_a.dtype), rope_2d(k_a)], axis=1)
        v_all = jnp.concatenate([ctx_v.astype(v_a.dtype), v_a], axis=1)
    else:
        q_use, k_all, v_all = q_a, k_a, v_a
    o_a = block_attention(q_use, k_all, v_all)
    qr = q_r.reshape(b, L, N_RET_HEADS, RET_KEY_DIM).transpose(0, 2, 1, 3).astype(jnp.float32)
    kr = (k_r.reshape(b, L, N_RET_HEADS, RET_KEY_DIM).transpose(0, 2, 1, 3).astype(jnp.float32)
          * (RET_KEY_DIM ** -0.5))
    vr = v_r.reshape(b, L, N_RET_HEADS, RET_VAL_DIM).transpose(0, 2, 1, 3).astype(jnp.float32)
    if latent:
        s0_f = s0_f.astype(jnp.float32)
        s0_b = s0_b.astype(jnp.float32)
    else:
        s0_f = jnp.zeros((b, N_RET_HEADS, RET_KEY_DIM, RET_VAL_DIM), jnp.float32)
        s0_b = s0_f
    log_g_f = jax.nn.log_sigmoid(dec_f.astype(jnp.float32))
    log_g_b = jax.nn.log_sigmoid(dec_b.astype(jnp.float32))
    o_r, s_f, s_b = bidir_retention(qr, kr, vr, log_g_f, log_g_b, s0_f, s0_b)
    mu = jnp.mean(o_r, axis=-1, keepdims=True)
    var = jnp.mean(jnp.square(o_r - mu), axis=-1, keepdims=True)
    o_r = ((o_r - mu) * lax.rsqrt(var + EPS)).transpose(0, 2, 1, 3).reshape(b, L, RET_V)
    o_r = (o_r * ret_norm.astype(jnp.float32)).astype(h.dtype) * jax.nn.silu(g_r)
    merged = jax.nn.sigmoid(gate_a) * (o_a @ w_ba) + jax.nn.sigmoid(gate_r) * (o_r @ w_br)
    return merged @ w_out, k_a, v_a, s_f.astype(h.dtype), s_b.astype(h.dtype)


def swiglu(h, w_g, w_u, w_d):
    return (jax.nn.silu(h @ w_g) * (h @ w_u)) @ w_d


def layer(x, mod, norm_a, norm_f, w_in, q_norm, k_norm, dec_f, dec_b, ret_norm, w_ba, w_br, w_out,
          w_g, w_u, w_d, ctx_k, ctx_v, s0_f, s0_b, latent):
    sh_a, sc_a, g_a, sh_f, sc_f, g_f = jnp.split(mod, 6, axis=-1)
    h = rms_norm(x, norm_a) * (1.0 + sc_a) + sh_a
    mix, k_a, v_a, s_f, s_b = token_mixer(h, w_in, q_norm, k_norm, dec_f, dec_b, ret_norm, w_ba, w_br,
                                          w_out, ctx_k, ctx_v, s0_f, s0_b, latent)
    x = x + g_a * mix
    h = rms_norm(x, norm_f) * (1.0 + sc_f) + sh_f
    x = x + g_f * swiglu(h, w_g, w_u, w_d)
    return x, k_a, v_a, s_f, s_b


def setup_inputs(seed: int = 0) -> dict:
    key = jax.random.key(seed)
    ks = jax.random.split(key, 32)
    f32 = jnp.float32

    def nrm(k, shape, scale):
        return jax.random.normal(k, shape, f32) * scale

    base_decay = jnp.log(2.0 ** (5.0 + jnp.arange(N_RET_HEADS, dtype=f32)) - 1.0)
    return {
        'x_prompt': nrm(ks[0], (BATCH, SEQ, D_MODEL), 1.0),
        'x_sample': nrm(ks[1], (DEC_BATCH, DEC_SEQ, D_MODEL), 1.0),
        'cache_attn_k': nrm(ks[2], (DEC_BATCH, DEPTH, PAST_LEN, N_KV_HEADS, HEAD_DIM), 1.0),
        'cache_attn_v': nrm(ks[3], (DEC_BATCH, DEPTH, PAST_LEN, N_KV_HEADS, HEAD_DIM), 1.0),
        'state_ret_fwd': nrm(ks[4], (DEC_BATCH, DEPTH, N_RET_HEADS, RET_KEY_DIM, RET_VAL_DIM), 0.5),
        'state_ret_bwd': nrm(ks[5], (DEC_BATCH, DEPTH, N_RET_HEADS, RET_KEY_DIM, RET_VAL_DIM), 0.5),
        'c': nrm(ks[6], (DEC_BATCH, D_MODEL), 1.0),
        'c_ctx': nrm(ks[7], (D_MODEL,), 1.0),
        'norm_attn': 1.0 + nrm(ks[8], (DEPTH, D_MODEL), 0.01),
        'norm_ffn': 1.0 + nrm(ks[9], (DEPTH, D_MODEL), 0.01),
        'w_mod': nrm(ks[10], (DEPTH, D_MODEL, 6 * D_MODEL), 0.5 * D_MODEL ** -0.5),
        'b_mod': nrm(ks[11], (DEPTH, 6 * D_MODEL), 0.01),
        'w_in': nrm(ks[12], (DEPTH, D_MODEL, N_IN), D_MODEL ** -0.5),
        'q_norm': 1.0 + nrm(ks[13], (DEPTH, HEAD_DIM), 0.01),
        'k_norm': 1.0 + nrm(ks[14], (DEPTH, HEAD_DIM), 0.01),
        'ret_decay_fwd': base_decay[None, :] + nrm(ks[15], (DEPTH, N_RET_HEADS), 0.01),
        'ret_decay_bwd': base_decay[None, :] + nrm(ks[16], (DEPTH, N_RET_HEADS), 0.01),
        'ret_norm': 1.0 + nrm(ks[17], (DEPTH, RET_V), 0.01),
        'w_branch_attn': nrm(ks[18], (DEPTH, ATTN_Q, D_MODEL), ATTN_Q ** -0.5),
        'w_branch_ret': nrm(ks[19], (DEPTH, RET_V, D_MODEL), RET_V ** -0.5),
        'w_out': nrm(ks[20], (DEPTH, D_MODEL, D_MODEL), D_MODEL ** -0.5),
        'w_ffn_gate': nrm(ks[21], (DEPTH, D_MODEL, D_FF), D_MODEL ** -0.5),
        'w_ffn_up': nrm(ks[22], (DEPTH, D_MODEL, D_FF), D_MODEL ** -0.5),
        'w_ffn_down': nrm(ks[23], (DEPTH, D_FF, D_MODEL), D_FF ** -0.5),
        'final_norm': 1.0 + nrm(ks[24], (D_MODEL,), 0.01),
    }


def reference(x_prompt, x_sample, cache_attn_k, cache_attn_v, state_ret_fwd, state_ret_bwd, c, c_ctx,
              norm_attn, norm_ffn, w_mod, b_mod, w_in, q_norm, k_norm, ret_decay_fwd, ret_decay_bwd,
              ret_norm, w_branch_attn, w_branch_ret, w_out, w_ffn_gate, w_ffn_up, w_ffn_down, final_norm):
    xp, xs = x_prompt, x_sample
    new_k, new_v, new_sf, new_sb = [], [], [], []
    for l in range(DEPTH):
        mod_ctx = (jax.nn.silu(c_ctx) @ w_mod[l] + b_mod[l])[None, None, :]
        mod_lat = (jax.nn.silu(c) @ w_mod[l] + b_mod[l])[:, None, :]
        xp, k_l, v_l, sf_l, sb_l = layer(
            xp, mod_ctx, norm_attn[l], norm_ffn[l], w_in[l], q_norm[l], k_norm[l], ret_decay_fwd[l],
            ret_decay_bwd[l], ret_norm[l], w_branch_attn[l], w_branch_ret[l], w_out[l], w_ffn_gate[l],
            w_ffn_up[l], w_ffn_down[l], None, None, None, None, False)
        xs, _, _, _, _ = layer(
            xs, mod_lat, norm_attn[l], norm_ffn[l], w_in[l], q_norm[l], k_norm[l], ret_decay_fwd[l],
            ret_decay_bwd[l], ret_norm[l], w_branch_attn[l], w_branch_ret[l], w_out[l], w_ffn_gate[l],
            w_ffn_up[l], w_ffn_down[l], cache_attn_k[:, l], cache_attn_v[:, l], state_ret_fwd[:, l],
            state_ret_bwd[:, l], True)
        new_k.append(k_l)
        new_v.append(v_l)
        new_sf.append(sf_l)
        new_sb.append(sb_l)
    y_prompt = rms_norm(xp, final_norm)
    y_sample = rms_norm(xs, final_norm)
    return (y_prompt, y_sample, jnp.stack(new_k, axis=1), jnp.stack(new_v, axis=1),
            jnp.stack(new_sf, axis=1), jnp.stack(new_sb, axis=1))
```

```cpp
#include <hip/hip_runtime.h>
#include <hip/hip_cooperative_groups.h>
#include <cstdio>
#include <cstdint>
namespace cg = cooperative_groups;

#ifndef MK_MULTI
#define MK_MULTI 0
#endif

#ifndef PROBE_PH
#define PROBE_PH (-1)
#endif
#define REP(k) ((PROBE_PH == (k)) ? 2 : 1)
#define LAS __attribute__((address_space(3)))
typedef unsigned short bf16_t;
typedef short bf16x8 __attribute__((ext_vector_type(8)));
typedef short s16x4 __attribute__((ext_vector_type(4)));
typedef float f32x4 __attribute__((ext_vector_type(4)));
typedef float f32x8 __attribute__((ext_vector_type(8)));
typedef float f32x16 __attribute__((ext_vector_type(16)));
typedef unsigned u32x4 __attribute__((ext_vector_type(4)));
typedef unsigned u32x2 __attribute__((ext_vector_type(2)));

constexpr int DM = 2048, NTOK = 12288, NPR = 4096, NIN = 13312, DFF = 5632;
constexpr int NTHREADS = 512;
constexpr float EPS = 1e-6f;
constexpr size_t OUT_Y = 0, OUT_NK = 25165824, OUT_NV = 27262976, OUT_RF = 29360128, OUT_RB = 33554432;
constexpr size_t WS_WTIN = 0;
constexpr size_t WS_H    = 54525952;
constexpr size_t WS_SP   = 0;
constexpr size_t WS_WTD  = 0;
constexpr size_t WS_OCAT = 104857600;
constexpr size_t WS_KALL = 205520896;
constexpr size_t WS_VALL = WS_KALL + 12582912;
constexpr size_t WS_KP   = WS_VALL + 12582912;
constexpr size_t WS_VP   = WS_KP + 4194304;
constexpr size_t WS_RQK  = 239075328;
constexpr size_t WS_SGA  = 289406976;
constexpr size_t WS_SGR  = WS_SGA + 50331648;
constexpr size_t WS_RV   = WS_SGR + 50331648;
constexpr size_t WS_ACT  = WS_SGA;
constexpr size_t WS_WTCAT = 440401920;
constexpr size_t WS_WTOUT = WS_WTCAT + 16777216;
constexpr size_t WS_MODV = 465567744;
constexpr size_t WS_ROPE = WS_MODV + 442368;
constexpr size_t WS_BAR  = WS_ROPE + 16384;
constexpr size_t WS_CNT6 = WS_BAR + 16384;
constexpr size_t WS_CNT9 = WS_CNT6 + 16384;
constexpr size_t WS_SLOT6 = WS_CNT9 + 16384;
constexpr size_t WS_SLOT9 = WS_SLOT6 + 393216;
constexpr size_t WS_WTGU = WS_SLOT9 + 393216;
constexpr size_t WS_END  = WS_WTGU + 46137344;

constexpr int LDS_STAGE = 131072;
constexpr int LDS_X_OFF = LDS_STAGE;
constexpr int LDS_ST_OFF = LDS_STAGE + 16384;
constexpr int LDS_BYTES = LDS_ST_OFF + 16;

struct Params {
  const float* in[25];
  float* out; unsigned char* ws;
  int ph_lo, ph_hi, coop, pad;
};
enum { I_XP = 0, I_XS, I_CK, I_CV, I_SF, I_SB, I_C, I_CCTX, I_NA, I_NF, I_WMOD, I_BMOD, I_WIN, I_QN, I_KN, I_DF, I_DB, I_RN, I_WBA, I_WBR, I_WOUT, I_WG, I_WU, I_WD, I_FN };

__device__ __forceinline__ unsigned cvt_pk_bf16(float lo, float hi) { unsigned r; asm volatile("v_cvt_pk_bf16_f32 %0, %1, %2" : "=v"(r) : "v"(lo), "v"(hi)); return r; }
__device__ __forceinline__ float bf_lo(unsigned w) { return __uint_as_float(w << 16); }
__device__ __forceinline__ float bf_hi(unsigned w) { return __uint_as_float(w & 0xffff0000u); }
__device__ __forceinline__ bf16_t f2bf(float f) { unsigned u = __float_as_uint(f); u += 0x7fffu + ((u >> 16) & 1u); return (bf16_t)(u >> 16); }
__device__ __forceinline__ float fast_exp(float x) { return __builtin_amdgcn_exp2f(x * 1.4426950408889634f); }
__device__ __forceinline__ float sigmoidf_(float x) { return __builtin_amdgcn_rcpf(1.0f + fast_exp(-x)); }
__device__ __forceinline__ float siluf_(float x) { return x * sigmoidf_(x); }
__device__ __forceinline__ float wave_sum(float s) {
  s += __shfl_xor(s, 1); s += __shfl_xor(s, 2); s += __shfl_xor(s, 4); s += __shfl_xor(s, 8); s += __shfl_xor(s, 16); s += __shfl_xor(s, 32); return s; }
__device__ __forceinline__ unsigned off_b(unsigned row, unsigned ch) { return 256u * row + 16u * (ch ^ (((row & 3u) << 2) | ((row >> 2) & 3u))); }
__device__ __forceinline__ bf16x8 tr_frag(unsigned a0, unsigned a1) {
  s16x4 lo, hi;
  asm volatile("ds_read_b64_tr_b16 %0, %2\n\tds_read_b64_tr_b16 %1, %3\n\ts_waitcnt lgkmcnt(0)" : "=&v"(lo), "=&v"(hi) : "v"(a0), "v"(a1) : "memory");
  return (bf16x8){lo[0], lo[1], lo[2], lo[3], hi[0], hi[1], hi[2], hi[3]};
}
__device__ __forceinline__ float log2_sigmoid(float x) {
  return -log1pf(__expf(-x)) * 1.4426950408889634f; }

namespace pg8 {
constexpr int BM = 256, BK = 64, HALF = 128, HTB = HALF * BK * 2, STAGE_BYTES = 8 * HTB, NXCD = 8, WGM = 4;
__device__ __forceinline__ int lds_byte(int r, int c) { const int st = (r >> 4) * 2 + (c >> 5), rr = r & 15, cc = c & 31, ob = rr * 64 + cc * 2; return st * 1024 + (ob ^ (((ob >> 9) & 1) << 5)); }
__device__ __forceinline__ void stage_rc(int b, int& R, int& C) { const int st = b / 1024, sb = b % 1024, swz = sb ^ (((sb >> 9) & 1) << 5); R = (st >> 1) * 16 + swz / 64; C = (st & 1) * 32 + (swz % 64) / 2; }
__device__ __forceinline__ int perm32(int rho) { const int n = rho >> 4, i = rho & 15; return 8 * (i >> 2) + 4 * n + (i & 3); }
struct Unit { int pm, pn, seg; };
struct Gemm { const bf16_t* A; const bf16_t* Bt; int M, N, K, lda, ldb; };
struct StaticOrder {
  int nM, nN, nwg, G, c, imax;
  __device__ void init(int M, int N, int G_, int c_, int tm = BM) { nM = M / tm; nN = N / BM; nwg = nM * nN; G = G_; c = c_; imax = 1 << 30; }
  __device__ void unit_of(long L, Unit& u) const {
    int wgid = (int)L; { const int q = nwg / NXCD, r = nwg % NXCD, xcd = wgid % NXCD, off = wgid / NXCD; wgid = (xcd < r ? xcd * (q + 1) : r * (q + 1) + (xcd - r) * q) + off; }
    const int nig = WGM * nN, gid = wgid / nig, fm = gid * WGM, gsz = (nM - fm) < WGM ? (nM - fm) : WGM;
    u.pm = fm + ((wgid % nig) % gsz); u.pn = (wgid % nig) / gsz; }
  __device__ bool next(int i, Unit& u) const {
    const long L = (long)i * G + c; if (L >= nwg || i >= imax) return false;
    int wgid = (int)L; { const int q = nwg / NXCD, r = nwg % NXCD, xcd = wgid % NXCD, off = wgid / NXCD; wgid = (xcd < r ? xcd * (q + 1) : r * (q + 1) + (xcd - r) * q) + off; }
    const int nig = WGM * nN, gid = wgid / nig, fm = gid * WGM, gsz = (nM - fm) < WGM ? (nM - fm) : WGM;
    u.pm = fm + ((wgid % nig) % gsz); u.pn = (wgid % nig) / gsz; return true;
  }
};
template <class Epi, int MB = 4, class Ord = StaticOrder>
__device__ __forceinline__ void gemm_phase(LAS unsigned char* lds, const Gemm g, const Ord& S, const Epi& E) {
  int tid_ = threadIdx.x; asm volatile("" : "+v"(tid_));
  const int tid = tid_, wid = __builtin_amdgcn_readfirstlane(tid >> 6), lane = tid & 63, wr = wid >> 2, wc = wid & 3, fr = lane & 15, fq = lane >> 4;
  const int K = g.K, nt = K / BK;
  unsigned voffA[2], voffB[2];
#pragma unroll
  for (int i = 0; i < 2; ++i) { int R, C; stage_rc(tid * 16 + i * 8192, R, C); const int Rb = Epi::PERM ? ((R & ~31) + perm32(R & 31)) : R;
    voffA[i] = (unsigned)(R * g.lda + C) * 2u; voffB[i] = (unsigned)(Rb * g.ldb + C) * 2u; }
  const size_t kstep = (size_t)(BK * 2);
  const size_t hstepA = (size_t)(32 * MB) * g.lda * 2, hstepB = (size_t)HALF * g.ldb * 2;
  const size_t tstepA = 2 * hstepA, tstepB = 2 * hstepB, segb = (size_t)K * 2;
  const unsigned ldsw = (unsigned)wid * 1024u;
  const int aoff = lds_byte(wr * (16 * MB) + fr, fq * 8), boff = lds_byte(wc * 32 + fr, fq * 8);
#define PG8_SA(b, h) (((b) * 2 + (h)) * HTB)
#define PG8_SB(b, h) ((4 + (b) * 2 + (h)) * HTB)
#define PG8_STAGE(bufoff, gbase, voff) do { _Pragma("unroll") for (int _i = 0; _i < 2; ++_i) \
    __builtin_amdgcn_global_load_lds((const unsigned*)((const char*)(gbase) + (voff)[_i]), (LAS unsigned*)(lds + (bufoff) + ldsw + _i * 8192), 16, 0, 0); } while (0)
#define PG8_STAGEA(bufoff, gbase) do { __builtin_amdgcn_global_load_lds((const unsigned*)((const char*)(gbase) + voffA[0]), (LAS unsigned*)(lds + (bufoff) + ldsw), 16, 0, 0); \
    if (!(MB == 3 && wr == 1)) __builtin_amdgcn_global_load_lds((const unsigned*)((const char*)(gbase) + voffA[1]), (LAS unsigned*)(lds + (bufoff) + ldsw + 8192), 16, 0, 0); } while (0)
#define PG8_LDA(dst, b, h) do { _Pragma("unroll") for (int m = 0; m < MB; ++m) _Pragma("unroll") for (int k = 0; k < 2; ++k) dst[m][k] = *(const LAS bf16x8*)(lds + PG8_SA(b, h) + aoff + m * 2048 + k * 1024); } while (0)
#define PG8_LDB(dst, b, h) do { _Pragma("unroll") for (int n = 0; n < 2; ++n) _Pragma("unroll") for (int k = 0; k < 2; ++k) dst[n][k] = *(const LAS bf16x8*)(lds + PG8_SB(b, h) + boff + n * 2048 + k * 1024); } while (0)
#define PG8_MMA(ai, bj, At, Bt) do { __builtin_amdgcn_s_setprio(1); _Pragma("unroll") for (int m = 0; m < MB; ++m) _Pragma("unroll") for (int n = 0; n < 2; ++n) _Pragma("unroll") for (int k = 0; k < 2; ++k) \
    acc[ai][bj][m][n] = __builtin_amdgcn_mfma_f32_16x16x32_bf16(Bt[n][k], At[m][k], acc[ai][bj][m][n], 0, 0, 0); __builtin_amdgcn_s_setprio(0); } while (0)
#define PG8_WAIT_V(n) asm volatile("s_waitcnt vmcnt(" #n ")" ::: "memory")
#define PG8_WAIT_V6() do { if (MB == 3 && wr == 1) asm volatile("s_waitcnt vmcnt(5)" ::: "memory"); else asm volatile("s_waitcnt vmcnt(6)" ::: "memory"); } while (0)
#define PG8_WAIT_V4() do { if (MB == 3 && wr == 1) asm volatile("s_waitcnt vmcnt(3)" ::: "memory"); else asm volatile("s_waitcnt vmcnt(4)" ::: "memory"); } while (0)
#define PG8_WAIT_L(n) asm volatile("s_waitcnt lgkmcnt(" #n ")" ::: "memory")
#define PG8_BAR __builtin_amdgcn_s_barrier()
#define PG8_SCHED __builtin_amdgcn_sched_barrier(0)
  Unit cur, nxt; int ui = 0;
  if (!S.next(0, cur)) return;
  cur.seg = 0;
  f32x4 acc[2][2][MB][2];
#pragma unroll
  for (int a = 0; a < 2; ++a)
#pragma unroll
    for (int b = 0; b < 2; ++b)
#pragma unroll
      for (int m = 0; m < MB; ++m)
#pragma unroll
        for (int n = 0; n < 2; ++n) acc[a][b][m][n] = (f32x4){0.f, 0.f, 0.f, 0.f};
  bf16x8 At[MB][2], B0[2][2], B1[2][2];
  const char* cA = (const char*)g.A + (size_t)cur.pm * tstepA + (Epi::KSPLIT ? (size_t)(cur.pn & 1) * segb : 0); const char* cB = (const char*)g.Bt + (size_t)(Epi::KSPLIT ? cur.pn >> 1 : cur.pn) * tstepB + (Epi::KSPLIT ? (size_t)(cur.pn & 1) * segb : 0);
  PG8_STAGE(PG8_SB(0, 0), cB, voffB); PG8_STAGEA(PG8_SA(0, 0), cA); PG8_STAGE(PG8_SB(0, 1), cB + hstepB, voffB); PG8_STAGEA(PG8_SA(0, 1), cA + hstepA);
  if (wr == 1) PG8_BAR;
  PG8_WAIT_V4(); PG8_BAR;
  PG8_STAGE(PG8_SB(1, 0), cB + kstep, voffB); PG8_STAGEA(PG8_SA(1, 0), cA + kstep); PG8_STAGE(PG8_SB(1, 1), cB + hstepB + kstep, voffB);
  PG8_WAIT_V6(); PG8_BAR;
  for (;;) {
    bool has_next;
    if (Epi::NSEG > 1 && cur.seg + 1 < Epi::NSEG) { nxt = cur; nxt.seg = cur.seg + 1; has_next = true; }
    else { has_next = S.next(ui + 1, nxt); nxt.seg = 0; }
    const size_t nko = Epi::KSPLIT ? (size_t)(nxt.pn & 1) * segb : (size_t)nxt.seg * segb;
    const char* nA = has_next ? (const char*)g.A + (size_t)nxt.pm * tstepA + nko : cA; const char* nB = has_next ? (const char*)g.Bt + (size_t)(Epi::KSPLIT ? nxt.pn >> 1 : nxt.pn) * tstepB + nko : cB;
    for (int t = 0; t < nt; t += 2) {
      const bool last = (t == nt - 2);
      const char* a1 = cA + (size_t)(t + 1) * kstep;
      const char* a2 = last ? nA : cA + (size_t)(t + 2) * kstep; const char* b2 = last ? nB : cB + (size_t)(t + 2) * kstep;
      const char* a3 = a2 + kstep; const char* b3 = b2 + kstep;
      PG8_LDB(B0, 0, 0); PG8_SCHED; PG8_LDA(At, 0, 0); PG8_STAGEA(PG8_SA(1, 1), a1 + hstepA);
      PG8_WAIT_L(8); PG8_BAR; PG8_WAIT_L(0); PG8_MMA(0, 0, At, B0); PG8_BAR; PG8_SCHED;
      PG8_LDB(B1, 0, 1); PG8_STAGE(PG8_SB(0, 0), b2, voffB);
      PG8_BAR; PG8_WAIT_L(0); PG8_MMA(0, 1, At, B1); PG8_BAR;
      PG8_LDA(At, 0, 1); PG8_STAGEA(PG8_SA(0, 0), a2);
      PG8_BAR; PG8_WAIT_L(0); PG8_MMA(1, 0, At, B0); PG8_BAR; PG8_SCHED;
      PG8_STAGE(PG8_SB(0, 1), b2 + hstepB, voffB);
      PG8_WAIT_V6(); PG8_BAR; PG8_MMA(1, 1, At, B1); PG8_BAR;
      PG8_LDB(B0, 1, 0); PG8_SCHED; PG8_LDA(At, 1, 0); PG8_STAGEA(PG8_SA(0, 1), a2 + hstepA);
      PG8_WAIT_L(8); PG8_BAR; PG8_WAIT_L(0); PG8_MMA(0, 0, At, B0); PG8_BAR; PG8_SCHED;
      PG8_LDB(B1, 1, 1); PG8_STAGE(PG8_SB(1, 0), b3, voffB);
      PG8_BAR; PG8_WAIT_L(0); PG8_MMA(0, 1, At, B1); PG8_BAR;
      PG8_LDA(At, 1, 1); PG8_STAGEA(PG8_SA(1, 0), a3);
      PG8_BAR; PG8_WAIT_L(0); PG8_MMA(1, 0, At, B0); PG8_BAR; PG8_SCHED;
      PG8_STAGE(PG8_SB(1, 1), b3 + hstepB, voffB);
      PG8_WAIT_V6(); PG8_BAR; PG8_MMA(1, 1, At, B1); PG8_BAR;
    }
    E(acc, cur, wr, wc, fr, fq);
    if (!has_next) break;
    if (Epi::NSEG == 1 || nxt.seg == 0) {
#pragma unroll
    for (int a = 0; a < 2; ++a)
#pragma unroll
      for (int b = 0; b < 2; ++b)
#pragma unroll
        for (int m = 0; m < MB; ++m)
#pragma unroll
          for (int n = 0; n < 2; ++n) acc[a][b][m][n] = (f32x4){0.f, 0.f, 0.f, 0.f};
    ++ui; }
    cur = nxt; cA = nA; cB = nB;
  }
  PG8_WAIT_V(0);
  if (wr == 0) PG8_BAR;
  PG8_BAR;
#undef PG8_SA
#undef PG8_SB
#undef PG8_STAGE
#undef PG8_STAGEA
#undef PG8_WAIT_V6
#undef PG8_WAIT_V4
#undef PG8_LDA
#undef PG8_LDB
#undef PG8_MMA
#undef PG8_WAIT_V
#undef PG8_WAIT_L
#undef PG8_BAR
#undef PG8_SCHED
}
}
using pg8::Unit;

__device__ __forceinline__ u32x4 pack8(f32x4 a, f32x4 b) { u32x4 w; w.x = cvt_pk_bf16(a[0], a[1]); w.y = cvt_pk_bf16(a[2], a[3]); w.z = cvt_pk_bf16(b[0], b[1]); w.w = cvt_pk_bf16(b[2], b[3]); return w; }

struct EpiIn {
  static constexpr bool PERM = true, KSPLIT = false; static constexpr int NSEG = 1;
  unsigned char* ws; float* out; const float* qnorm; const float* knorm; LAS float* X;
  __device__ __forceinline__ void operator()(f32x4 (&acc)[2][2][4][2], const Unit& u, int wr, int wc, int fr, int fq) const {
    const int pn = u.pn, pm = u.pm; const bool sample = pm >= 16;
    if (pn < 10) {
      const bool isq = pn < 8; const float* gw = isq ? qnorm : knorm;
      const int half = wc >> 1, i0 = (wc & 1) * 16 + fq * 4;
      const f32x4 g1 = *(const f32x4*)(gw + half * 64 + i0), g2 = *(const f32x4*)(gw + half * 64 + 32 + i0);
#pragma unroll
      for (int ai = 0; ai < 2; ++ai)
#pragma unroll
        for (int m = 0; m < 4; ++m)
#pragma unroll
          for (int bj = 0; bj < 2; ++bj) {
            const f32x4 a = acc[ai][bj][m][0], b = acc[ai][bj][m][1];
            float s = (a[0] * a[0] + a[1] * a[1]) + (a[2] * a[2] + a[3] * a[3]) + (b[0] * b[0] + b[1] * b[1]) + (b[2] * b[2] + b[3] * b[3]);
            s += __shfl_xor(s, 16); s += __shfl_xor(s, 32);
            if (fq == 0) X[(ai * 128 + wr * 64 + m * 16 + fr) * 8 + bj * 4 + wc] = s;
          }
      asm volatile("s_waitcnt lgkmcnt(0)" ::: "memory"); __builtin_amdgcn_s_barrier(); asm volatile("" ::: "memory");
      const float* ropeC = (const float*)(ws + WS_ROPE); const float* ropeS = ropeC + 2048;
#pragma unroll
      for (int ai = 0; ai < 2; ++ai)
#pragma unroll
        for (int m = 0; m < 4; ++m) {
          const int rl = ai * 128 + wr * 64 + m * 16 + fr, row = pm * 256 + rl;
          const int t = (row - NPR) & 1023;
          f32x4 cs = (f32x4){1.f, 1.f, 1.f, 1.f}, sn = (f32x4){0.f, 0.f, 0.f, 0.f};
          if (sample) { const int pos = half ? (t & 63) : (t >> 6); cs = *(const f32x4*)(ropeC + pos * 32 + i0); sn = *(const f32x4*)(ropeS + pos * 32 + i0); }
#pragma unroll
          for (int bj = 0; bj < 2; ++bj) {
            const f32x4 xs = *(const LAS f32x4*)(X + rl * 8 + bj * 4);
            const float rstd = __builtin_amdgcn_rsqf(((xs[0] + xs[1]) + (xs[2] + xs[3])) * (1.0f / 128.0f) + EPS);
            const f32x4 x1 = acc[ai][bj][m][0] * rstd * g1, x2 = acc[ai][bj][m][1] * rstd * g2;
            const f32x4 o1 = x1 * cs - x2 * sn, o2 = x2 * cs + x1 * sn;
            const u32x4 w = pack8(o1, o2);
            const int cin = bj * 128 + wc * 32 + fq * 8;
            if (isq) { *(u32x4*)((bf16_t*)(ws + WS_OCAT) + (size_t)row * 4096 + pn * 256 + cin) = w; }
            else {
              const int kvh = (pn - 8) * 2 + bj, cc = kvh * 128 + wc * 32 + fq * 8;
              if (!sample) {
                *(u32x4*)((bf16_t*)(ws + WS_KP) + (size_t)row * 512 + cc) = w;
                float* ok = out + OUT_NK + (size_t)row * 512 + kvh * 128 + half * 64 + i0;
                *(f32x4*)ok = o1; *(f32x4*)(ok + 32) = o2;
              } else {
                const int bs = (pm - 16) >> 2;
                *(u32x4*)((bf16_t*)(ws + WS_KALL) + ((size_t)bs * 1536 + 512 + t) * 512 + cc) = w;
              }
            }
          }
        }
    } else if (pn < 12) {
#pragma unroll
      for (int ai = 0; ai < 2; ++ai)
#pragma unroll
        for (int m = 0; m < 4; ++m) {
          const int rl = ai * 128 + wr * 64 + m * 16 + fr, row = pm * 256 + rl; const int t = (row - NPR) & 1023;
#pragma unroll
          for (int bj = 0; bj < 2; ++bj) {
            const f32x4 a = acc[ai][bj][m][0], b = acc[ai][bj][m][1]; const u32x4 w = pack8(a, b);
            const int kvh = (pn - 10) * 2 + bj, cc = kvh * 128 + wc * 32 + fq * 8;
            if (!sample) {
              *(u32x4*)((bf16_t*)(ws + WS_VP) + (size_t)row * 512 + cc) = w;
              float* ov = out + OUT_NV + (size_t)row * 512 + cc; *(f32x4*)ov = a; *(f32x4*)(ov + 4) = b;
            } else {
              const int bs = (pm - 16) >> 2;
              *(u32x4*)((bf16_t*)(ws + WS_VALL) + ((size_t)bs * 1536 + 512 + t) * 512 + cc) = w;
            }
          }
        }
    } else {
      bf16_t* base; int ld, col0, act;
      if (pn < 20) { base = (bf16_t*)(ws + WS_RQK); ld = 2048; col0 = (pn - 12) * 256; act = 0; }
      else if (pn < 28) { base = (bf16_t*)(ws + WS_RV); ld = 2048; col0 = (pn - 20) * 256; act = 0; }
      else if (pn < 36) { base = (bf16_t*)(ws + WS_OCAT); ld = 4096; col0 = 2048 + (pn - 28) * 256; act = 1; }
      else if (pn < 44) { base = (bf16_t*)(ws + WS_SGA); ld = 2048; col0 = (pn - 36) * 256; act = 2; }
      else { base = (bf16_t*)(ws + WS_SGR); ld = 2048; col0 = (pn - 44) * 256; act = 2; }
#pragma unroll
      for (int ai = 0; ai < 2; ++ai)
#pragma unroll
        for (int m = 0; m < 4; ++m) {
          const int row = pm * 256 + ai * 128 + wr * 64 + m * 16 + fr;
          bf16_t* rowp = base + (size_t)row * ld + col0 + wc * 32 + fq * 8;
#pragma unroll
          for (int bj = 0; bj < 2; ++bj) {
            f32x4 a = acc[ai][bj][m][0], b = acc[ai][bj][m][1];
            if (act == 1) {
#pragma unroll
              for (int j = 0; j < 4; ++j) { a[j] = siluf_(a[j]); b[j] = siluf_(b[j]); } }
            else if (act == 2) {
#pragma unroll
              for (int j = 0; j < 4; ++j) { a[j] = sigmoidf_(a[j]); b[j] = sigmoidf_(b[j]); } }
            *(u32x4*)(rowp + bj * 128) = pack8(a, b);
          }
        }
    }
  }
};

template <int MB> struct EpiMerge {
  static constexpr bool PERM = true, KSPLIT = false; static constexpr int NSEG = 2;
  const bf16_t* sga; const bf16_t* sgr; bf16_t* merged;
  __device__ __forceinline__ void mid(f32x4 (&acc)[2][2][MB][2], const Unit& u, int wr, int wc, int fr, int fq) const {
#pragma unroll
    for (int ai = 0; ai < 2; ++ai)
#pragma unroll
      for (int m = 0; m < MB; ++m) {
        const int row = u.pm * (64 * MB) + ai * (32 * MB) + wr * (16 * MB) + m * 16 + fr;
#pragma unroll
        for (int bj = 0; bj < 2; ++bj) {
          const size_t off = (size_t)row * 2048 + u.pn * 256 + bj * 128 + wc * 32 + fq * 8;
          const u32x4 a = *(const u32x4*)(sga + off), r = *(const u32x4*)(sgr + off);
          f32x4 q0, q1;
          q0[0] = bf_lo(a.x) * __builtin_amdgcn_rcpf(bf_lo(r.x)); q0[1] = bf_hi(a.x) * __builtin_amdgcn_rcpf(bf_hi(r.x));
          q0[2] = bf_lo(a.y) * __builtin_amdgcn_rcpf(bf_lo(r.y)); q0[3] = bf_hi(a.y) * __builtin_amdgcn_rcpf(bf_hi(r.y));
          q1[0] = bf_lo(a.z) * __builtin_amdgcn_rcpf(bf_lo(r.z)); q1[1] = bf_hi(a.z) * __builtin_amdgcn_rcpf(bf_hi(r.z));
          q1[2] = bf_lo(a.w) * __builtin_amdgcn_rcpf(bf_lo(r.w)); q1[3] = bf_hi(a.w) * __builtin_amdgcn_rcpf(bf_hi(r.w));
          acc[ai][bj][m][0] *= q0; acc[ai][bj][m][1] *= q1;
        }
      }
  }
  __device__ __forceinline__ void operator()(f32x4 (&acc)[2][2][MB][2], const Unit& u, int wr, int wc, int fr, int fq) const {
    if (u.seg == 0) { mid(acc, u, wr, wc, fr, fq); return; }
#pragma unroll
    for (int ai = 0; ai < 2; ++ai)
#pragma unroll
      for (int m = 0; m < MB; ++m) {
        const int row = u.pm * (64 * MB) + ai * (32 * MB) + wr * (16 * MB) + m * 16 + fr;
#pragma unroll
        for (int bj = 0; bj < 2; ++bj) {
          const size_t off = (size_t)row * 2048 + u.pn * 256 + bj * 128 + wc * 32 + fq * 8;
          const u32x4 r = *(const u32x4*)(sgr + off);
          const f32x4 r0 = (f32x4){bf_lo(r.x), bf_hi(r.x), bf_lo(r.y), bf_hi(r.y)}, r1 = (f32x4){bf_lo(r.z), bf_hi(r.z), bf_lo(r.w), bf_hi(r.w)};
          *(u32x4*)(merged + off) = pack8(acc[ai][bj][m][0] * r0, acc[ai][bj][m][1] * r1);
        }
      }
  }
};

template <int MB> struct EpiRes {
  static constexpr bool PERM = false, KSPLIT = false; static constexpr int NSEG = 1;
  const float* xa; const float* xb; float* Y; const float* gate;
  __device__ __forceinline__ void operator()(f32x4 (&acc)[2][2][MB][2], const Unit& u, int wr, int wc, int fr, int fq) const {
    const int cbase = u.pn * 256 + wc * 32 + fq * 4;
#pragma unroll
    for (int ai = 0; ai < 2; ++ai)
#pragma unroll
      for (int m = 0; m < MB; ++m) {
        const int row = u.pm * (64 * MB) + ai * (32 * MB) + wr * (16 * MB) + m * 16 + fr;
        const int mi = row < NPR ? 8 : (row - NPR) >> 10;
        const float* gp = gate + (size_t)mi * 12288 + cbase;
        const float* xr = (row < NPR ? xa + (size_t)row * 2048 : xb + (size_t)(row - NPR) * 2048) + cbase;
        float* yr = Y + (size_t)row * 2048 + cbase;
#pragma unroll
        for (int bj = 0; bj < 2; ++bj)
#pragma unroll
          for (int n = 0; n < 2; ++n) { const f32x4 xv = *(const f32x4*)(xr + bj * 128 + n * 16), gv = *(const f32x4*)(gp + bj * 128 + n * 16);
            *(f32x4*)(yr + bj * 128 + n * 16) = xv + gv * acc[ai][bj][m][n]; }
        asm volatile("" ::: "memory");
      }
  }
};


struct PanelOrder {
  int c;
  __device__ void init(int c_) { c = c_; }
  __device__ bool next(int i, Unit& u) const { if (i >= 2) return false; const int j = c >> 3; u.pm = i * 32 + (c & 7) * 4 + (j >> 3); u.pn = j & 7; return true; }
};
template <int MODE> struct EpiResNorm {
  static constexpr bool PERM = false, KSPLIT = false; static constexpr int NSEG = 1;
  const float* xa; const float* xb; float* Y; const float* modv; int gidx; const float* normw; bf16_t* H; float* slots; unsigned* cnt; LAS float* X;
  __device__ __forceinline__ void operator()(f32x4 (&acc)[2][2][3][2], const Unit& u, int wr, int wc, int fr, int fq) const {
    int lane = threadIdx.x & 63; asm volatile("" : "+v"(lane));
    const int cbase = u.pn * 256 + wc * 32 + fq * 4;
#pragma unroll
    for (int ai = 0; ai < 2; ++ai)
#pragma unroll
      for (int m = 0; m < 3; ++m) {
        const int rl = ai * 96 + wr * 48 + m * 16 + fr, row = u.pm * 192 + rl;
        const int mi = row < NPR ? 8 : (row - NPR) >> 10;
        const float* gp = modv + (size_t)mi * 12288 + gidx * 2048 + cbase;
        const float* xr = (row < NPR ? xa + (size_t)row * 2048 : xb + (size_t)(row - NPR) * 2048) + cbase;
        float ss = 0.f;
#pragma unroll
        for (int bj = 0; bj < 2; ++bj)
#pragma unroll
          for (int n = 0; n < 2; ++n) { const f32x4 xv = *(const f32x4*)(xr + bj * 128 + n * 16), gv = *(const f32x4*)(gp + bj * 128 + n * 16);
            const f32x4 v = xv + gv * acc[ai][bj][m][n]; acc[ai][bj][m][n] = v;
            if (MODE == 0) *(f32x4*)(Y + (size_t)row * 2048 + cbase + bj * 128 + n * 16) = v;
            ss += (v[0] * v[0] + v[1] * v[1]) + (v[2] * v[2] + v[3] * v[3]); }
        ss += __shfl_xor(ss, 16); ss += __shfl_xor(ss, 32);
        if (fq == 0) X[rl * 4 + wc] = ss;
        if (m == 2) asm volatile("" ::: "memory");
      }
    asm volatile("s_waitcnt lgkmcnt(0)" ::: "memory"); __builtin_amdgcn_s_barrier(); asm volatile("" ::: "memory");
    if (wc < 2) {
      const int t = wc * 64 + lane;
      if (t < 96) { const int rl = (t / 48) * 96 + wr * 48 + (t % 48);
        const f32x4 p = *(const LAS f32x4*)(X + rl * 4);
        __hip_atomic_store(slots + ((size_t)(u.pm * 192 + rl)) * 8 + u.pn, (p[0] + p[1]) + (p[2] + p[3]), __ATOMIC_RELAXED, __HIP_MEMORY_SCOPE_AGENT); }
      asm volatile("s_waitcnt vmcnt(0)" ::: "memory");
      if (lane == 0) __hip_atomic_fetch_add(cnt + 64 * u.pm, 1u, __ATOMIC_RELAXED, __HIP_MEMORY_SCOPE_AGENT);
    }
    asm volatile("" ::: "memory"); __builtin_amdgcn_s_barrier(); asm volatile("" ::: "memory");
    if (wc == 0) { unsigned sp = 0;
      while ((unsigned)__builtin_amdgcn_readfirstlane(__hip_atomic_load(cnt + 64 * u.pm, __ATOMIC_RELAXED, __HIP_MEMORY_SCOPE_AGENT)) < 32u) { __builtin_amdgcn_s_sleep(2); if (++sp > (1u << 20)) break; }
      __builtin_amdgcn_fence(__ATOMIC_ACQUIRE, "agent");
      asm volatile("s_waitcnt vmcnt(0)" ::: "memory"); }
    asm volatile("" ::: "memory"); __builtin_amdgcn_s_barrier(); asm volatile("" ::: "memory");
#pragma unroll
    for (int ai = 0; ai < 2; ++ai)
#pragma unroll
      for (int m = 0; m < 3; ++m) {
        const int rl = ai * 96 + wr * 48 + m * 16 + fr, row = u.pm * 192 + rl;
        const unsigned long long* sl = (const unsigned long long*)(slots + (size_t)row * 8);
        float ssq = 0.f;
#pragma unroll
        for (int q = 0; q < 4; ++q) { const unsigned long long w2 = __hip_atomic_load(sl + q, __ATOMIC_RELAXED, __HIP_MEMORY_SCOPE_AGENT); ssq += __uint_as_float((unsigned)w2) + __uint_as_float((unsigned)(w2 >> 32)); }
        const float rstd = 1.0f / sqrtf(ssq * (1.0f / 2048.0f) + EPS);
        if (MODE == 0) {
          const int mi = row < NPR ? 8 : (row - NPR) >> 10; const float* mv = modv + (size_t)mi * 12288 + cbase;
#pragma unroll
          for (int bj = 0; bj < 2; ++bj)
#pragma unroll
            for (int n = 0; n < 2; ++n) { const int co = bj * 128 + n * 16;
              const f32x4 w = *(const f32x4*)(normw + cbase + co), sc = *(const f32x4*)(mv + 4 * 2048 + co), sh = *(const f32x4*)(mv + 3 * 2048 + co);
              const f32x4 y = acc[ai][bj][m][n] * rstd * w * (1.0f + sc) + sh;
              u32x2 o; o.x = cvt_pk_bf16(y[0], y[1]); o.y = cvt_pk_bf16(y[2], y[3]);
              *(u32x2*)(H + (size_t)row * 2048 + cbase + co) = o; }
        } else {
#pragma unroll
          for (int bj = 0; bj < 2; ++bj)
#pragma unroll
            for (int n = 0; n < 2; ++n) { const int co = bj * 128 + n * 16;
              const f32x4 w = *(const f32x4*)(normw + cbase + co);
              *(f32x4*)(Y + (size_t)row * 2048 + cbase + co) = acc[ai][bj][m][n] * rstd * w; }
        }
        if (m == 2) asm volatile("" ::: "memory");
      }
  }
};

struct TailOrder {
  pg8::StaticOrder S; int L0, ntail, c;
  __device__ bool next(int i, Unit& u) const { if (i != 0 || (c >> 2) >= ntail) return false; S.unit_of(L0 + (c >> 2), u); u.pm = u.pm * 4 + (c & 3); return true; }
};
template <int MB> struct EpiGU {
  static constexpr bool PERM = true, KSPLIT = false; static constexpr int NSEG = 1;
  bf16_t* act;
  __device__ __forceinline__ void operator()(f32x4 (&acc)[2][2][MB][2], const Unit& u, int wr, int wc, int fr, int fq) const {
#pragma unroll
    for (int ai = 0; ai < 2; ++ai)
#pragma unroll
      for (int m = 0; m < MB; ++m) {
        const int row = u.pm * (64 * MB) + ai * (32 * MB) + wr * (16 * MB) + m * 16 + fr;
        bf16_t* rp = act + (size_t)row * DFF + u.pn * 128 + wc * 16 + fq * 4;
#pragma unroll
        for (int bj = 0; bj < 2; ++bj) {
          const f32x4 g = acc[ai][bj][m][0], up = acc[ai][bj][m][1];
          u32x2 w; w.x = cvt_pk_bf16(siluf_(g[0]) * up[0], siluf_(g[1]) * up[1]); w.y = cvt_pk_bf16(siluf_(g[2]) * up[2], siluf_(g[3]) * up[3]);
          *(u32x2*)(rp + bj * 64) = w;
        }
      }
  }
};

struct CvtJob { const float* src; const float* src2; int ldsrc; bf16_t* dst; int lddst; int dcol0; int nKt; int mode; };
__device__ __forceinline__ void cvt_addr(const CvtJob& J, int tile, int e, int kk, const float*& p, int& rloc) {
  const int Rt = tile / J.nKt, Kt = tile % J.nKt;
  int scol; const float* sp = J.src;
  if (J.mode == 2) { const int n = e >> 6, cc = e & 63; scol = Rt * 64 + cc; sp = n ? J.src2 : J.src; rloc = 32 * (cc >> 4) + 8 * ((cc >> 2) & 3) + 4 * n + (cc & 3); }
  else { scol = Rt * 128 + e; rloc = e;
    if (J.mode == 1 && Rt < 20) { const int half = e >> 6, n = (e >> 5) & 1, i = e & 31; rloc = 32 * (half * 2 + (i >> 4)) + 8 * ((i >> 2) & 3) + 4 * n + (i & 3); } }
  p = sp + (size_t)(Kt * 128 + kk) * J.ldsrc + scol;
}
__device__ __forceinline__ void cvt_tiles(const CvtJob& J, int t0, int tend, int stride, LAS unsigned char* lds) {
  if (t0 >= tend) return;
  int tid_ = threadIdx.x; asm volatile("" : "+v"(tid_));
  const int tid = tid_, e = tid & 127, kk = tid >> 7;
  const float* p; int rloc; float v[32], vn[32];
  cvt_addr(J, t0, e, kk, p, rloc);
#pragma unroll
  for (int i = 0; i < 32; ++i) v[i] = __builtin_nontemporal_load(p + (size_t)(4 * i) * J.ldsrc);
  int buf = 0;
  __syncthreads();
  for (int t = t0; t < tend; t += stride) {
    LAS bf16_t* T = (LAS bf16_t*)(lds + buf * (128 * 136 * 2));
#pragma unroll
    for (int i = 0; i < 32; ++i) T[rloc * 136 + kk + 4 * i] = f2bf(v[i]);
    const int tn = t + stride; int rlocn = rloc;
    if (tn < tend) { const float* pn; cvt_addr(J, tn, e, kk, pn, rlocn);
#pragma unroll
      for (int i = 0; i < 32; ++i) vn[i] = __builtin_nontemporal_load(pn + (size_t)(4 * i) * J.ldsrc); }
    __syncthreads();
    const int Rt = t / J.nKt, Kt = t % J.nKt;
#pragma unroll
    for (int it = 0; it < 4; ++it) { const int ch = tid + 512 * it, row = ch >> 4, c8 = ch & 15;
      const u32x4 w = *(const LAS u32x4*)(T + row * 136 + c8 * 8);
      *(u32x4*)(J.dst + (size_t)(Rt * 128 + row) * J.lddst + J.dcol0 + Kt * 128 + c8 * 8) = w; }
    if (tn < tend) {
#pragma unroll
      for (int i = 0; i < 32; ++i) v[i] = vn[i]; }
    rloc = rlocn; buf ^= 1;
  }
  __syncthreads();
}

__device__ __forceinline__ void phase_prep_gemv(const Params& P, LAS unsigned char* lds, float* modv) {
  const int tid = threadIdx.x, G = gridDim.x, bid = blockIdx.x;
  {
    LAS float* Sv = (LAS float*)lds;
    LAS float* Rd = (LAS float*)(lds + 8192);
    const float* wmod = P.in[I_WMOD];
    for (int item = bid; item < 768; item += G) {
      const int cb = item % 48, ks = item / 48;
      for (int idx = tid; idx < 9 * 128; idx += NTHREADS) { const int vi = idx >> 7, kk = idx & 127;
        const float x = vi < 8 ? P.in[I_C][vi * 2048 + ks * 128 + kk] : P.in[I_CCTX][ks * 128 + kk]; Sv[idx] = siluf_(x); }
      __syncthreads();
      const int lane = tid & 63, wave = tid >> 6, col = cb * 256 + lane * 4;
      f32x4 a[9];
#pragma unroll
      for (int vi = 0; vi < 9; ++vi) a[vi] = (f32x4){0.f, 0.f, 0.f, 0.f};
#pragma unroll 4
      for (int r = 0; r < 16; ++r) { const int k = wave + 8 * r; const f32x4 w = __builtin_nontemporal_load((const f32x4*)(wmod + (size_t)(ks * 128 + k) * 12288 + col));
#pragma unroll
        for (int vi = 0; vi < 9; ++vi) a[vi] += Sv[vi * 128 + k] * w; }
#pragma unroll
      for (int vi = 0; vi < 9; ++vi) *(LAS f32x4*)(Rd + (wave * 9 + vi) * 256 + lane * 4) = a[vi];
      __syncthreads();
      for (int idx = tid; idx < 9 * 256; idx += NTHREADS) { const int vi = idx >> 8, c = idx & 255; float s = 0.f;
#pragma unroll
        for (int w = 0; w < 8; ++w) s += Rd[(w * 9 + vi) * 256 + c];
        if (ks == 0) s += P.in[I_BMOD][cb * 256 + c];
        atomicAdd(modv + vi * 12288 + cb * 256 + c, s); }
      __syncthreads();
    }
  }
}
__device__ __forceinline__ void phase_prep_rest(const Params& P, LAS unsigned char* lds) {
  const int tid = threadIdx.x, G = gridDim.x, bid = blockIdx.x;
  unsigned char* ws = P.ws;
  {
    CvtJob J1{P.in[I_WIN], nullptr, NIN, (bf16_t*)(ws + WS_WTIN), 2048, 0, 16, 1};
    cvt_tiles(J1, bid, 104 * 16, G, lds);
    CvtJob J2{P.in[I_WBA], nullptr, 2048, (bf16_t*)(ws + WS_WTCAT), 4096, 0, 16, 0};
    cvt_tiles(J2, bid, 16 * 16, G, lds);
    CvtJob J3{P.in[I_WBR], nullptr, 2048, (bf16_t*)(ws + WS_WTCAT), 4096, 2048, 16, 0};
    cvt_tiles(J3, bid, 16 * 16, G, lds);
    CvtJob J4{P.in[I_WOUT], nullptr, 2048, (bf16_t*)(ws + WS_WTOUT), 2048, 0, 16, 0};
    cvt_tiles(J4, bid, 16 * 16, G, lds);
  }
  {
    const float* ck = P.in[I_CK]; const float* cv = P.in[I_CV];
    bf16_t* kall = (bf16_t*)(ws + WS_KALL); bf16_t* vall = (bf16_t*)(ws + WS_VALL);
    for (int idx = bid * NTHREADS + tid; idx < 262144; idx += G * NTHREADS) {
      const int pc = idx & 15, kvh = (idx >> 4) & 3, t = (idx >> 6) & 511, bs = idx >> 15;
      const size_t src = ((size_t)(bs * 512 + t) * 4 + kvh) * 128, dst = ((size_t)bs * 1536 + t) * 512 + kvh * 128 + pc * 8;
      const int wc = pc >> 2, fq = pc & 3, half = wc >> 1, i0 = (wc & 1) * 16 + fq * 4;
      const f32x4 k1 = *(const f32x4*)(ck + src + half * 64 + i0), k2 = *(const f32x4*)(ck + src + half * 64 + 32 + i0);
      *(u32x4*)(kall + dst) = pack8(k1, k2);
      const f32x4 v1 = *(const f32x4*)(cv + src + pc * 8), v2 = *(const f32x4*)(cv + src + pc * 8 + 4);
      *(u32x4*)(vall + dst) = pack8(v1, v2);
    }
  }
  {
    float* ropeC = (float*)(ws + WS_ROPE); float* ropeS = ropeC + 2048;
    for (int idx = bid * NTHREADS + tid; idx < 2048; idx += G * NTHREADS) {
      const int pos = idx >> 5, i = idx & 31;
      const float inv = __builtin_amdgcn_exp2f(-(float)i * (13.287712379549449f / 32.0f));
      float rev = (float)pos * inv * 0.15915494309189535f; rev -= floorf(rev);
      ropeC[idx] = __builtin_amdgcn_cosf(rev); ropeS[idx] = __builtin_amdgcn_sinf(rev);
    }
  }
}

__device__ __forceinline__ void phase_modnorm(const float* xa, const float* xb, const float* normw, const float* modv, int sh_idx, int sc_idx, bf16_t* outp) {
  const int lane = threadIdx.x & 63, wave = threadIdx.x >> 6;
  for (int row = blockIdx.x * 8 + wave; row < NTOK; row += gridDim.x * 8) {
    const float* xr = row < NPR ? xa + (size_t)row * 2048 : xb + (size_t)(row - NPR) * 2048;
    f32x4 v[8]; float ss = 0.f;
#pragma unroll
    for (int i = 0; i < 8; ++i) { v[i] = *(const f32x4*)(xr + i * 256 + lane * 4); ss += (v[i][0] * v[i][0] + v[i][1] * v[i][1]) + (v[i][2] * v[i][2] + v[i][3] * v[i][3]); }
    ss = wave_sum(ss);
    const float rstd = 1.0f / sqrtf(ss * (1.0f / 2048.0f) + EPS);
    const int mi = row < NPR ? 8 : (row - NPR) >> 10; const float* mv = modv + (size_t)mi * 12288;
#pragma unroll
    for (int i = 0; i < 8; ++i) { const int c = i * 256 + lane * 4;
      const f32x4 w = *(const f32x4*)(normw + c), sc = *(const f32x4*)(mv + sc_idx * 2048 + c), sh = *(const f32x4*)(mv + sh_idx * 2048 + c);
      const f32x4 y = v[i] * rstd * w * (1.0f + sc) + sh;
      u32x2 o; o.x = cvt_pk_bf16(y[0], y[1]); o.y = cvt_pk_bf16(y[2], y[3]);
      *(u32x2*)(outp + (size_t)row * 2048 + c) = o; }
  }
}
__device__ __forceinline__ void phase_finalnorm(float* Y, const float* normw) {
  const int lane = threadIdx.x & 63, wave = threadIdx.x >> 6;
  for (int row = blockIdx.x * 8 + wave; row < NTOK; row += gridDim.x * 8) {
    float* xr = Y + (size_t)row * 2048;
    f32x4 v[8]; float ss = 0.f;
#pragma unroll
    for (int i = 0; i < 8; ++i) { v[i] = *(const f32x4*)(xr + i * 256 + lane * 4); ss += (v[i][0] * v[i][0] + v[i][1] * v[i][1]) + (v[i][2] * v[i][2] + v[i][3] * v[i][3]); }
    ss = wave_sum(ss);
    const float rstd = 1.0f / sqrtf(ss * (1.0f / 2048.0f) + EPS);
#pragma unroll
    for (int i = 0; i < 8; ++i) { const int c = i * 256 + lane * 4; const f32x4 w = *(const f32x4*)(normw + c); *(f32x4*)(xr + c) = v[i] * rstd * w; }
  }
}

namespace att {
constexpr int D = 128, NW = 8, QBLK = 32, KVBLK = 64;
constexpr float SCALE = 0.088388347648318440f;
constexpr float THR = 8.f;
constexpr int LDQ = 4096, LDK = 512, LDO = 4096;
constexpr size_t SHM_V = KVBLK * D * 2, SHM_K = KVBLK * D * 2, SHM_ATTN = 2 * SHM_V + 2 * SHM_K + NW * 64 * 4;
#define KSWZ(row, colB) ((row) * 256 + ((colB) ^ (((row) & 7) << 4)))
#define SBAR() __builtin_amdgcn_sched_barrier(0)
__device__ __forceinline__ int crow(int r, int hi) { return (r & 3) + 8 * (r >> 2) + 4 * hi; }
__device__ __forceinline__ void partialSM(f32x16& p0, f32x16& p1, float& m_reg, float& mn, float& alpha) {
  constexpr float C = SCALE * 1.4426950408889634f;
  float pmax = p0[0];
#pragma unroll
  for (int r = 1; r < 16; ++r) pmax = fmaxf(pmax, p0[r]);
#pragma unroll
  for (int r = 0; r < 16; ++r) pmax = fmaxf(pmax, p1[r]);
  { auto rr = __builtin_amdgcn_permlane32_swap(__float_as_uint(pmax), __float_as_uint(pmax), false, false);
    pmax = fmaxf(__uint_as_float(rr[0]), __uint_as_float(rr[1])); }
  if (__builtin_expect(__all(pmax - m_reg <= THR / SCALE), 1)) { mn = m_reg; alpha = 1.f; }
  else { mn = fmaxf(m_reg, pmax); alpha = __builtin_amdgcn_exp2f((m_reg - mn) * C); m_reg = mn; }
  float mnC = -mn * C;
#pragma unroll
  for (int r = 0; r < 16; ++r) p0[r] = fmaf(p0[r], C, mnC);
#pragma unroll
  for (int r = 0; r < 16; ++r) p1[r] = fmaf(p1[r], C, mnC);
#pragma unroll
  for (int r = 0; r < 16; ++r) p0[r] = __builtin_amdgcn_exp2f(p0[r]);
}
__device__ __forceinline__ void finishSM(f32x16& p0, f32x16& p1, float alpha, float& l_reg, bf16x8& pa0, bf16x8& pa1, bf16x8& pa2, bf16x8& pa3) {
#pragma unroll
  for (int r = 0; r < 16; ++r) p1[r] = __builtin_amdgcn_exp2f(p1[r]);
  float ps = 0;
#pragma unroll
  for (int r = 0; r < 16; ++r) ps += p0[r];
#pragma unroll
  for (int r = 0; r < 16; ++r) ps += p1[r];
  { auto rr = __builtin_amdgcn_permlane32_swap(__float_as_uint(ps), __float_as_uint(ps), false, false);
    ps = __uint_as_float(rr[0]) + __uint_as_float(rr[1]); }
  l_reg = l_reg * alpha + ps;
#define PK4(P, BASE, OUT) do { unsigned a0 = cvt_pk_bf16(P[BASE + 0], P[BASE + 1]), a1 = cvt_pk_bf16(P[BASE + 2], P[BASE + 3]);   \
    unsigned b0 = cvt_pk_bf16(P[BASE + 4], P[BASE + 5]), b1 = cvt_pk_bf16(P[BASE + 6], P[BASE + 7]);                              \
    auto r0 = __builtin_amdgcn_permlane32_swap(a0, b0, false, false); auto r1 = __builtin_amdgcn_permlane32_swap(a1, b1, false, false); \
    u32x4 w = {r0[0], r1[0], r0[1], r1[1]}; OUT = *reinterpret_cast<bf16x8*>(&w); } while (0)
  PK4(p0, 0, pa0); PK4(p0, 8, pa1); PK4(p1, 0, pa2); PK4(p1, 8, pa3);
#undef PK4
}
__device__ __forceinline__ void qkt(f32x16& p0, f32x16& p1, const bf16_t* Ks, const bf16x8* qr, int r32, int hi) {
  p0 = f32x16{}; p1 = f32x16{};
#pragma unroll
  for (int d0 = 0; d0 < 8; ++d0) { int cb = (d0 * 16 + hi * 8) * 2;
    bf16x8 b0 = *reinterpret_cast<const bf16x8*>((const char*)Ks + KSWZ(r32, cb));
    bf16x8 b1 = *reinterpret_cast<const bf16x8*>((const char*)Ks + KSWZ(32 + r32, cb));
    p0 = __builtin_amdgcn_mfma_f32_32x32x16_bf16(b0, qr[d0], p0, 0, 0, 0);
    p1 = __builtin_amdgcn_mfma_f32_32x32x16_bf16(b1, qr[d0], p1, 0, 0, 0); }
}
__device__ __forceinline__ int v_st(int k, int c) { const int kk = (k & ~0xC) | ((k & 4) << 1) | ((k & 8) >> 1); return ((kk >> 3) * 4 + (c >> 5)) * 512 + ((kk & 7) * 32 + (c & 31)) * 2; }
__device__ __forceinline__ int v_rd_base(int lane) { return ((lane & 3) << 3) | (((lane >> 2) & 3) << 6) | (((lane >> 4) & 1) << 5) | (((lane >> 5) & 1) << 8); }
constexpr int v_rd_off(int d0, int ks, int half) { return d0 * 512 + ks * 4096 + half * 2048; }
template <int OFF> __device__ __forceinline__ s16x4 tr_read(int vb) {
  s16x4 r; asm volatile("ds_read_b64_tr_b16 %0, %1 offset:%2" : "=&v"(r) : "v"(vb), "i"(OFF) : "memory"); return r;
}
template <int D0> __device__ __forceinline__ void pv_one(f32x16& od, int vb, bf16x8 pa0, bf16x8 pa1, bf16x8 pa2, bf16x8 pa3) {
  const s16x4 l0 = tr_read<v_rd_off(D0, 0, 0)>(vb), h0 = tr_read<v_rd_off(D0, 0, 1)>(vb), l1 = tr_read<v_rd_off(D0, 1, 0)>(vb), h1 = tr_read<v_rd_off(D0, 1, 1)>(vb);
  const s16x4 l2 = tr_read<v_rd_off(D0, 2, 0)>(vb), h2 = tr_read<v_rd_off(D0, 2, 1)>(vb), l3 = tr_read<v_rd_off(D0, 3, 0)>(vb), h3 = tr_read<v_rd_off(D0, 3, 1)>(vb);
  asm volatile("s_waitcnt lgkmcnt(0)" ::: "memory"); SBAR();
#define PK(L, H) (bf16x8){L[0], L[1], L[2], L[3], H[0], H[1], H[2], H[3]}
  od = __builtin_amdgcn_mfma_f32_32x32x16_bf16(pa0, PK(l0, h0), od, 0, 0, 0);
  od = __builtin_amdgcn_mfma_f32_32x32x16_bf16(pa1, PK(l1, h1), od, 0, 0, 0);
  od = __builtin_amdgcn_mfma_f32_32x32x16_bf16(pa2, PK(l2, h2), od, 0, 0, 0);
  od = __builtin_amdgcn_mfma_f32_32x32x16_bf16(pa3, PK(l3, h3), od, 0, 0, 0);
#undef PK
}
__device__ __forceinline__ void pv_d0(f32x16* o, int vb, bf16x8 pa0, bf16x8 pa1, bf16x8 pa2, bf16x8 pa3) {
  pv_one<0>(o[0], vb, pa0, pa1, pa2, pa3); pv_one<1>(o[1], vb, pa0, pa1, pa2, pa3); pv_one<2>(o[2], vb, pa0, pa1, pa2, pa3); pv_one<3>(o[3], vb, pa0, pa1, pa2, pa3);
}
__device__ __forceinline__ void attn_body(const bf16_t* __restrict__ Qb, const bf16_t* __restrict__ Kh, const bf16_t* __restrict__ Vh, bf16_t* __restrict__ Ob, int seq, char* lds) {
  int tid_ = threadIdx.x; asm volatile("" : "+v"(tid_));
  const int tid = tid_, wid = tid >> 6, lane = tid & 63, r32 = lane & 31, hi = lane >> 5;
  bf16_t* V_lds = (bf16_t*)lds; bf16_t* K_lds = (bf16_t*)(lds + 2 * SHM_V);
  float* wsl = (float*)(lds + 2 * SHM_V + 2 * SHM_K) + wid * 64; float* li_l = wsl; float* al_l = wsl + 32;
  float m_reg = -1e30f, l_reg = 0; f32x16 o[4] = {}; bf16x8 qr[8];
  const bf16_t* Qw = Qb + (long)(wid * QBLK + r32) * LDQ + hi * 8;
#pragma unroll
  for (int d0 = 0; d0 < 8; ++d0) qr[d0] = *reinterpret_cast<const bf16x8*>(Qw + d0 * 16);
  const int sr = tid >> 4, sc = (tid & 15) * 8, vst0 = v_st(sr, sc), vst1 = v_st(32 + sr, sc);
  const int vb0 = (int)(uintptr_t)V_lds + v_rd_base(lane);
  struct { bf16x8 vs0, vs1, ks0, ks1; } sr_[2];
#define SLOAD(i, k0) do { sr_[i].vs0 = *reinterpret_cast<const bf16x8*>(&Vh[(long)((k0) + sr) * LDK + sc]); sr_[i].vs1 = *reinterpret_cast<const bf16x8*>(&Vh[(long)((k0) + 32 + sr) * LDK + sc]); \
    sr_[i].ks0 = *reinterpret_cast<const bf16x8*>(&Kh[(long)((k0) + sr) * LDK + sc]); sr_[i].ks1 = *reinterpret_cast<const bf16x8*>(&Kh[(long)((k0) + 32 + sr) * LDK + sc]); } while (0)
#define SWRITE(b, i) do { *(bf16x8*)((char*)V_lds + (b) * SHM_V + vst0) = sr_[i].vs0;          \
    *(bf16x8*)((char*)V_lds + (b) * SHM_V + vst1) = sr_[i].vs1; int kc = sc * 2;               \
    *(bf16x8*)((char*)K_lds + (b) * SHM_K + KSWZ(sr, kc)) = sr_[i].ks0;                       \
    *(bf16x8*)((char*)K_lds + (b) * SHM_K + KSWZ(32 + sr, kc)) = sr_[i].ks1; } while (0)
#define SWAIT() asm volatile("s_waitcnt vmcnt(4)" ::: "memory")
#define RESC(a) do { if (__any((a) < 1.f)) { if (hi == 0) al_l[r32] = (a); asm volatile("s_waitcnt lgkmcnt(0)" ::: "memory"); \
    _Pragma("unroll") for (int d = 0; d < 4; ++d) _Pragma("unroll") for (int r = 0; r < 16; ++r) o[d][r] *= al_l[crow(r, hi)]; } } while (0)
  f32x16 pA0, pA1, pB0, pB1; float mnA, mnB, alA, alB; bf16x8 pa0, pa1, pa2, pa3; const int NT = seq / KVBLK;
  constexpr int SE = 0, SO = 1;
  SLOAD(SE, 0); asm volatile("s_waitcnt vmcnt(0)" ::: "memory"); SWRITE(0, SE); __syncthreads();
  qkt(pA0, pA1, K_lds, qr, r32, hi); partialSM(pA0, pA1, m_reg, mnA, alA);
  SLOAD(SO, KVBLK); if (2 < NT) SLOAD(SE, 2 * KVBLK);
  SWAIT(); SWRITE(1, SO); __syncthreads();
  for (int j = 1; j + 1 < NT; j += 2) {
    SBAR(); qkt(pB0, pB1, (bf16_t*)((char*)K_lds + SHM_K), qr, r32, hi);
    finishSM(pA0, pA1, alA, l_reg, pa0, pa1, pa2, pa3); SBAR();
    SLOAD(SO, (j + 2) * KVBLK); SBAR();
    pv_d0(o, vb0, pa0, pa1, pa2, pa3); partialSM(pB0, pB1, m_reg, mnB, alB);
    __syncthreads(); SWAIT(); SWRITE(0, SE);
    RESC(alB); __syncthreads();
    SBAR(); qkt(pA0, pA1, K_lds, qr, r32, hi);
    finishSM(pB0, pB1, alB, l_reg, pa0, pa1, pa2, pa3); SBAR();
    if (j + 3 < NT) SLOAD(SE, (j + 3) * KVBLK); SBAR();
    pv_d0(o, vb0 + (int)SHM_V, pa0, pa1, pa2, pa3); partialSM(pA0, pA1, m_reg, mnA, alA);
    __syncthreads(); SWAIT(); SWRITE(1, SO);
    RESC(alA); __syncthreads();
  }
  SBAR(); qkt(pB0, pB1, (bf16_t*)((char*)K_lds + SHM_K), qr, r32, hi);
  finishSM(pA0, pA1, alA, l_reg, pa0, pa1, pa2, pa3); SBAR();
  pv_d0(o, vb0, pa0, pa1, pa2, pa3); partialSM(pB0, pB1, m_reg, mnB, alB);
  __syncthreads(); RESC(alB);
  finishSM(pB0, pB1, alB, l_reg, pa0, pa1, pa2, pa3); SBAR();
  pv_d0(o, vb0 + (int)SHM_V, pa0, pa1, pa2, pa3);
  if (hi == 0) li_l[r32] = l_reg; asm volatile("s_waitcnt lgkmcnt(0)" ::: "memory");
  float rli[16];
#pragma unroll
  for (int r = 0; r < 16; ++r) rli[r] = __builtin_amdgcn_rcpf(li_l[crow(r, hi)]);
  bf16_t* Ow = Ob + (long)(wid * QBLK) * LDO;
#pragma unroll
  for (int r = 0; r < 16; ++r) { int orow = crow(r, hi);
#pragma unroll
    for (int d0 = 0; d0 < 4; ++d0) Ow[(long)orow * LDO + d0 * 32 + r32] = f2bf(o[d0][r] * rli[r]); }
#undef SLOAD
#undef SWRITE
#undef SWAIT
#undef RESC
}
}

constexpr int RP = 272;
__device__ __forceinline__ bf16x8 tr2(LAS unsigned char* p0, LAS unsigned char* p1) {
  const s16x4 lo = __builtin_amdgcn_ds_read_tr16_b64_v4i16((LAS s16x4*)p0), hi = __builtin_amdgcn_ds_read_tr16_b64_v4i16((LAS s16x4*)p1);
  return (bf16x8){lo[0], lo[1], lo[2], lo[3], hi[0], hi[1], hi[2], hi[3]};
}
__device__ __forceinline__ void ret_state_item(const Params& P, int item, LAS unsigned char* lds) {
  int tid_ = threadIdx.x; asm volatile("" : "+v"(tid_));
  const int tid = tid_, lane = tid & 63, w = tid >> 6, l15 = lane & 15, g = lane >> 4;
  unsigned char* ws = P.ws;
  const bool heavy = item < 256; const int id = heavy ? item : item - 256;
  const int half = id & 1, dir = (id >> 1) & 1, h = (id >> 2) & 7, bb = id >> 5;
  const int nc = heavy ? 8 : 2, row0 = heavy ? NPR + bb * 1024 : bb * 256, gc0 = heavy ? 32 + bb * 8 : bb * 2;
  const float l2g = log2_sigmoid(P.in[dir ? I_DB : I_DF][h]);
  const float G128 = __builtin_amdgcn_exp2f(128.0f * l2g);
  const bf16_t* rqk = (const bf16_t*)(ws + WS_RQK); const bf16_t* rv = (const bf16_t*)(ws + WS_RV); bf16_t* sp = (bf16_t*)(ws + WS_SP);
  const int r0 = tid >> 4, ch = tid & 15;
  const bf16_t* kg = rqk + (size_t)(row0 + r0) * 2048 + 1024 + h * 128 + ch * 8;
  const bf16_t* vg = rv + (size_t)(row0 + r0) * 2048 + h * 256 + half * 128 + ch * 8;
  u32x4 kq[4], vq[4];
  { const int c = dir ? nc - 1 : 0;
#pragma unroll
    for (int it = 0; it < 4; ++it) { kq[it] = *(const u32x4*)(kg + (size_t)(c * 128 + it * 32) * 2048); vq[it] = *(const u32x4*)(vg + (size_t)(c * 128 + it * 32) * 2048); } }
  f32x4 acc[8];
  if (heavy) { const float* s0 = P.in[dir ? I_SB : I_SF] + ((size_t)(bb * 8 + h) * 128) * 256;
#pragma unroll
    for (int nb = 0; nb < 8; ++nb)
#pragma unroll
      for (int jj = 0; jj < 4; ++jj) acc[nb][jj] = s0[(size_t)(16 * w + 4 * g + jj) * 256 + half * 128 + 16 * nb + l15]; }
  else {
#pragma unroll
    for (int nb = 0; nb < 8; ++nb) acc[nb] = (f32x4){0.f, 0.f, 0.f, 0.f}; }
  const int q4 = l15 >> 2, p4 = lane & 3;
  __syncthreads();
  float zr[4];
#pragma unroll
  for (int it = 0; it < 4; ++it) { const int r = r0 + 32 * it; zr[it] = __builtin_amdgcn_exp2f((float)(dir ? r : 127 - r) * l2g) * 0.088388347648318440f; }
  for (int step = 0; step < nc; ++step) {
    const int c = dir ? nc - 1 - step : step, gc = gc0 + c;
    LAS unsigned char* Kimg = lds + (step & 1) * (256 * RP); LAS unsigned char* Vimg = Kimg + 128 * RP;
    LAS unsigned char* ka = Kimg + (8 * g + q4) * RP + (16 * w + 4 * p4) * 2;
    LAS unsigned char* va = Vimg + (8 * g + q4) * RP + (4 * p4) * 2;
#pragma unroll
    for (int it = 0; it < 4; ++it) { const int r = r0 + 32 * it; const float z = zr[it]; const u32x4 kv = kq[it];
      u32x4 ks; ks.x = cvt_pk_bf16(bf_lo(kv.x) * z, bf_hi(kv.x) * z); ks.y = cvt_pk_bf16(bf_lo(kv.y) * z, bf_hi(kv.y) * z);
      ks.z = cvt_pk_bf16(bf_lo(kv.z) * z, bf_hi(kv.z) * z); ks.w = cvt_pk_bf16(bf_lo(kv.w) * z, bf_hi(kv.w) * z);
      *(LAS u32x4*)(Kimg + r * RP + ch * 16) = ks; *(LAS u32x4*)(Vimg + r * RP + ch * 16) = vq[it]; }
    __syncthreads();
    if (step + 1 < nc) { const int cn = dir ? nc - 2 - step : step + 1;
#pragma unroll
      for (int it = 0; it < 4; ++it) { kq[it] = *(const u32x4*)(kg + (size_t)(cn * 128 + it * 32) * 2048); vq[it] = *(const u32x4*)(vg + (size_t)(cn * 128 + it * 32) * 2048); } }
    { bf16_t* spb = sp + ((size_t)(gc * 8 + h) * 2 + dir) * 32768;
#pragma unroll
      for (int nb = 0; nb < 8; ++nb) { const int dv = half * 128 + 16 * nb + l15;
        u32x2 wv; wv.x = cvt_pk_bf16(acc[nb][0], acc[nb][1]); wv.y = cvt_pk_bf16(acc[nb][2], acc[nb][3]);
        *(u32x2*)(spb + (size_t)dv * 128 + 16 * w + 4 * g) = wv; } }
#pragma unroll
    for (int nb = 0; nb < 8; ++nb) acc[nb] *= G128;
    { bf16x8 fa[2], fb[2][8];
      fa[0] = tr2(ka, ka + 4 * RP);
#pragma unroll
      for (int nb = 0; nb < 8; ++nb) fb[0][nb] = tr2(va + nb * 32, va + 4 * RP + nb * 32);
#pragma unroll
      for (int ks = 0; ks < 4; ++ks) {
        if (ks < 3) { fa[(ks + 1) & 1] = tr2(ka + (ks + 1) * 32 * RP, ka + (ks + 1) * 32 * RP + 4 * RP);
#pragma unroll
          for (int nb = 0; nb < 8; ++nb) fb[(ks + 1) & 1][nb] = tr2(va + (ks + 1) * 32 * RP + nb * 32, va + (ks + 1) * 32 * RP + 4 * RP + nb * 32); }
        __builtin_amdgcn_sched_barrier(0);
#pragma unroll
        for (int nb = 0; nb < 8; ++nb) acc[nb] = __builtin_amdgcn_mfma_f32_16x16x32_bf16(fa[ks & 1], fb[ks & 1][nb], acc[nb], 0, 0, 0);
        __builtin_amdgcn_sched_barrier(0);
      } }
  }
  if (!heavy) { float* o = P.out + (dir ? OUT_RB : OUT_RF) + ((size_t)(bb * 8 + h) * 128) * 256;
#pragma unroll
    for (int nb = 0; nb < 8; ++nb)
#pragma unroll
      for (int jj = 0; jj < 4; ++jj) o[(size_t)(16 * w + 4 * g + jj) * 256 + half * 128 + 16 * nb + l15] = acc[nb][jj]; }
}

constexpr int R2_Q = 0, R2_P = 34816, R2_V = 69632, R2_VP = 528, R2_ST = 139264;
__device__ __forceinline__ void ret_out_item(const Params& P, int item, LAS unsigned char* lds, bf16_t* ocat_out) {
  int tid_ = threadIdx.x; asm volatile("" : "+v"(tid_));
  const int tid = tid_, lane = tid & 63, w = tid >> 6, l15 = lane & 15, g = lane >> 4;
  unsigned char* ws = P.ws;
  const int h = item & 7, gc = item >> 3; const size_t row0 = (size_t)gc * 128;
  const float l2gf = log2_sigmoid(P.in[I_DF][h]), l2gb = log2_sigmoid(P.in[I_DB][h]);
  const bf16_t* rqk = (const bf16_t*)(ws + WS_RQK); const bf16_t* rv = (const bf16_t*)(ws + WS_RV); const bf16_t* sp = (const bf16_t*)(ws + WS_SP);
  const bf16_t* ocat = (const bf16_t*)(ws + WS_OCAT);
  LAS unsigned char* Qi = lds + R2_Q; LAS unsigned char* Pl = lds + R2_P; LAS unsigned char* Vi = lds + R2_V;
  { u32x4 qv[4], vv[8];
#pragma unroll
    for (int it = 0; it < 4; ++it) { const int chid = tid + 512 * it, r = chid >> 4, ch = chid & 15; qv[it] = *(const u32x4*)(rqk + (row0 + r) * 2048 + h * 128 + ch * 8); }
#pragma unroll
    for (int it = 0; it < 8; ++it) { const int chid = tid + 512 * it, r = chid >> 5, ch = chid & 31; vv[it] = *(const u32x4*)(rv + (row0 + r) * 2048 + h * 256 + ch * 8); }
#pragma unroll
    for (int it = 0; it < 4; ++it) { const int chid = tid + 512 * it, r = chid >> 4, ch = chid & 15; *(LAS u32x4*)(Qi + r * RP + ch * 16) = qv[it]; }
#pragma unroll
    for (int it = 0; it < 8; ++it) { const int chid = tid + 512 * it, r = chid >> 5, ch = chid & 31; *(LAS u32x4*)(Vi + r * R2_VP + ch * 16) = vv[it]; } }
  bf16x8 kf[4], sf[2][4], sb[2][4];
  { const bf16_t* kp = rqk + (row0 + 16 * w + l15) * 2048 + 1024 + h * 128 + 8 * g;
#pragma unroll
    for (int ks = 0; ks < 4; ++ks) kf[ks] = *(const bf16x8*)(kp + 32 * ks);
    const bf16_t* sfp = sp + ((size_t)(gc * 8 + h) * 2) * 32768 + (size_t)(32 * w + l15) * 128 + 8 * g;
#pragma unroll
    for (int rb = 0; rb < 2; ++rb)
#pragma unroll
      for (int ks = 0; ks < 4; ++ks) { sf[rb][ks] = *(const bf16x8*)(sfp + rb * 16 * 128 + 32 * ks); sb[rb][ks] = *(const bf16x8*)(sfp + 32768 + rb * 16 * 128 + 32 * ks); } }
  __syncthreads();
  LAS unsigned char* qa = Qi + l15 * RP + (8 * g) * 2;
  f32x4 sT[8];
  { bf16x8 qb[2][4];
#pragma unroll
    for (int ks = 0; ks < 4; ++ks) qb[0][ks] = *(const LAS bf16x8*)(qa + ks * 64);
#pragma unroll
    for (int ib = 0; ib < 8; ++ib) {
      if (ib < 7) {
#pragma unroll
        for (int ks = 0; ks < 4; ++ks) qb[(ib + 1) & 1][ks] = *(const LAS bf16x8*)(qa + (ib + 1) * 16 * RP + ks * 64); }
      __builtin_amdgcn_sched_barrier(0);
      f32x4 t = (f32x4){0.f, 0.f, 0.f, 0.f};
#pragma unroll
      for (int ks = 0; ks < 4; ++ks) t = __builtin_amdgcn_mfma_f32_16x16x32_bf16(kf[ks], qb[ib & 1][ks], t, 0, 0, 0);
      sT[ib] = t;
      __builtin_amdgcn_sched_barrier(0);
    } }
#pragma unroll
  for (int ib = 0; ib < 8; ++ib) { const int i = 16 * ib + l15; float pv[4];
#pragma unroll
    for (int jj = 0; jj < 4; ++jj) { const int j = 16 * w + 4 * g + jj, d = i - j;
      const float mf = d >= 0 ? __builtin_amdgcn_exp2f((float)d * l2gf) : 0.f, mb = d <= 0 ? __builtin_amdgcn_exp2f((float)(-d) * l2gb) : 0.f;
      pv[jj] = sT[ib][jj] * (mf + mb) * 0.088388347648318440f; }
    u32x2 wv; wv.x = cvt_pk_bf16(pv[0], pv[1]); wv.y = cvt_pk_bf16(pv[2], pv[3]);
    *(LAS u32x2*)(Pl + ((ib * 4 + (w >> 1)) * 64 + lane) * 16 + (w & 1) * 8) = wv; }
  __syncthreads();
  f32x4 o[2][8];
  { bf16x8 qb[2][4];
#pragma unroll
    for (int ks = 0; ks < 4; ++ks) qb[0][ks] = *(const LAS bf16x8*)(qa + ks * 64);
#pragma unroll
    for (int ib = 0; ib < 8; ++ib) { int i = 16 * ib + l15; asm volatile("" : "+v"(i));
      if (ib < 7) {
#pragma unroll
        for (int ks = 0; ks < 4; ++ks) qb[(ib + 1) & 1][ks] = *(const LAS bf16x8*)(qa + (ib + 1) * 16 * RP + ks * 64); }
      const float sc1 = __builtin_amdgcn_exp2f((float)(i + 1) * l2gf - (float)(128 - i) * l2gb);
      const float sc2 = __builtin_amdgcn_exp2f((float)(128 - i) * l2gb);
      __builtin_amdgcn_sched_barrier(0);
      f32x4 a0 = (f32x4){0.f, 0.f, 0.f, 0.f}, a1 = (f32x4){0.f, 0.f, 0.f, 0.f};
#pragma unroll
      for (int ks = 0; ks < 4; ++ks) { a0 = __builtin_amdgcn_mfma_f32_16x16x32_bf16(sf[0][ks], qb[ib & 1][ks], a0, 0, 0, 0); a1 = __builtin_amdgcn_mfma_f32_16x16x32_bf16(sf[1][ks], qb[ib & 1][ks], a1, 0, 0, 0); }
      a0 *= sc1; a1 *= sc1;
#pragma unroll
      for (int ks = 0; ks < 4; ++ks) { a0 = __builtin_amdgcn_mfma_f32_16x16x32_bf16(sb[0][ks], qb[ib & 1][ks], a0, 0, 0, 0); a1 = __builtin_amdgcn_mfma_f32_16x16x32_bf16(sb[1][ks], qb[ib & 1][ks], a1, 0, 0, 0); }
      o[0][ib] = a0 * sc2; o[1][ib] = a1 * sc2;
      __builtin_amdgcn_sched_barrier(0);
    } }
  u32x2 rg[2][8];
#pragma unroll
  for (int ib = 0; ib < 8; ++ib)
#pragma unroll
    for (int rb = 0; rb < 2; ++rb) rg[rb][ib] = *(const u32x2*)(ocat + (row0 + 16 * ib + l15) * 4096 + 2048 + h * 256 + 32 * w + 4 * g + rb * 16);
  { const int q4 = l15 >> 2, p4 = lane & 3;
    LAS unsigned char* va = Vi + (4 * g + q4) * R2_VP + (32 * w + 4 * p4) * 2;
    bf16x8 vf[2][4];
#pragma unroll
    for (int rb = 0; rb < 2; ++rb)
#pragma unroll
      for (int kb = 0; kb < 4; ++kb) vf[rb][kb] = tr2(va + kb * 32 * R2_VP + rb * 32, va + kb * 32 * R2_VP + 16 * R2_VP + rb * 32);
    bf16x8 pq[2][4];
#pragma unroll
    for (int kb = 0; kb < 4; ++kb) pq[0][kb] = *(const LAS bf16x8*)(Pl + (kb * 64 + lane) * 16);
#pragma unroll
    for (int ib = 0; ib < 8; ++ib) {
      if (ib < 7) {
#pragma unroll
        for (int kb = 0; kb < 4; ++kb) pq[(ib + 1) & 1][kb] = *(const LAS bf16x8*)(Pl + (((ib + 1) * 4 + kb) * 64 + lane) * 16); }
      __builtin_amdgcn_sched_barrier(0);
#pragma unroll
      for (int kb = 0; kb < 4; ++kb) {
        o[0][ib] = __builtin_amdgcn_mfma_f32_16x16x32_bf16(vf[0][kb], pq[ib & 1][kb], o[0][ib], 0, 0, 0);
        o[1][ib] = __builtin_amdgcn_mfma_f32_16x16x32_bf16(vf[1][kb], pq[ib & 1][kb], o[1][ib], 0, 0, 0); }
      __builtin_amdgcn_sched_barrier(0);
    } }
  LAS float* St = (LAS float*)(lds + R2_ST);
#pragma unroll
  for (int ib = 0; ib < 8; ++ib) { const f32x4 a = o[0][ib], b = o[1][ib];
    float s1 = (a[0] + a[1]) + (a[2] + a[3]) + (b[0] + b[1]) + (b[2] + b[3]);
    float s2 = (a[0] * a[0] + a[1] * a[1]) + (a[2] * a[2] + a[3] * a[3]) + (b[0] * b[0] + b[1] * b[1]) + (b[2] * b[2] + b[3] * b[3]);
    s1 += __shfl_xor(s1, 16); s1 += __shfl_xor(s1, 32); s2 += __shfl_xor(s2, 16); s2 += __shfl_xor(s2, 32);
    if (g == 0) { St[(w * 128 + 16 * ib + l15) * 2] = s1; St[(w * 128 + 16 * ib + l15) * 2 + 1] = s2; } }
  __syncthreads();
  const float* rn = P.in[I_RN] + h * 256 + 32 * w + 4 * g;
  const f32x4 wn0 = *(const f32x4*)rn, wn1 = *(const f32x4*)(rn + 16);
#pragma unroll
  for (int ib = 0; ib < 8; ++ib) { int i = 16 * ib + l15; asm volatile("" : "+v"(i)); float s1 = 0.f, s2 = 0.f;
#pragma unroll
    for (int ww = 0; ww < 8; ++ww) { s1 += St[(ww * 128 + i) * 2]; s2 += St[(ww * 128 + i) * 2 + 1]; }
    const float mu = s1 * (1.0f / 256.0f); const float var = fmaxf(s2 * (1.0f / 256.0f) - mu * mu, 0.f);
    const float rstd = 1.0f / sqrtf(var + EPS);
    const size_t ro = (row0 + i) * 4096 + 2048 + h * 256 + 32 * w + 4 * g;
#pragma unroll
    for (int rb = 0; rb < 2; ++rb) { const u32x2 gg = rg[rb][ib];
      const f32x4 y = (o[rb][ib] - mu) * rstd * (rb ? wn1 : wn0);
      u32x2 wv; wv.x = cvt_pk_bf16(y[0] * bf_lo(gg.x), y[1] * bf_hi(gg.x)); wv.y = cvt_pk_bf16(y[2] * bf_lo(gg.y), y[3] * bf_hi(gg.y));
      *(u32x2*)(ocat_out + ro + rb * 16) = wv; }
    asm volatile("" ::: "memory"); }
}


#define XB_TMO      128
#define XB_XCNT(j)  (256  + 64 * (j))
#define XB_XSUB(j)  (1280 + 64 * (j))
#define XB_XGEN(j)  (2304 + 64 * (j))
#define XB_TOP      3328
#define XB_TOPGEN   3392
#define XCD_BAR_WORDS 3456
#define XB_SPIN_CAP (1u << 18)
__device__ __forceinline__ unsigned xb_ld(unsigned* p)              { return __hip_atomic_load(p, __ATOMIC_RELAXED, __HIP_MEMORY_SCOPE_AGENT); }
__device__ __forceinline__ unsigned xb_add(unsigned* p, unsigned v) { return __hip_atomic_fetch_add(p, v, __ATOMIC_RELAXED, __HIP_MEMORY_SCOPE_AGENT); }
__device__ __forceinline__ unsigned xb_xcc_id() { return (unsigned)__builtin_amdgcn_s_getreg((3 << 11) | 20) & 0xFu; }
#define XB_SPIN(cond, bar) do { unsigned _sp = 0; while (cond) { __builtin_amdgcn_s_sleep(1); \
    if ((++_sp & 255u) == 0u) { if (xb_ld(&(bar)[XB_TMO])) break; if (_sp > XB_SPIN_CAP) { atomicAdd(&(bar)[XB_TMO], 1u); break; } } } } while (0)
struct XcdBarrier { unsigned* bar; unsigned x; volatile LAS unsigned* st; };
__device__ __forceinline__ XcdBarrier xcd_barrier_post(unsigned* bar, volatile LAS unsigned* st) {
  XcdBarrier b; b.bar = bar; b.x = xb_xcc_id(); b.st = st;
  if (threadIdx.x == 0) (void)xb_add(&bar[XB_XCNT(b.x)], 1u);
  return b;
}
__device__ __forceinline__ void xcd_barrier_complete(unsigned* bar, unsigned x, unsigned& nloc, unsigned& nx) {
  const unsigned G = gridDim.x * gridDim.y * gridDim.z;
  unsigned sum, cnt, mine, sp = 0u;
  for (;;) {
    sum = 0u; cnt = 0u; mine = 0u;
#pragma unroll
    for (unsigned j = 0; j < 16; ++j) { const unsigned c = xb_ld(&bar[XB_XCNT(j)]); sum += c; cnt += (c > 0u) ? 1u : 0u; mine = (j == x) ? c : mine; }
    if (sum == G) break;
    __builtin_amdgcn_s_sleep(1);
    if ((++sp & 255u) == 0u) { if (xb_ld(&bar[XB_TMO])) break; if (sp > XB_SPIN_CAP) { atomicAdd(&bar[XB_TMO], 1u); break; } }
  }
  nloc = mine > 0u ? mine : 1u; nx = cnt > 0u ? cnt : 1u;
}
__device__ __forceinline__ void xcd_barrier(const XcdBarrier& b) {
  asm volatile("s_waitcnt vmcnt(0)" ::: "memory");
  __syncthreads();
  if (threadIdx.x == 0) {
    unsigned* bar = b.bar;
    __builtin_amdgcn_s_waitcnt(0);
    unsigned nloc = b.st[0], nx = b.st[1];
    if (nloc == 0u) { xcd_barrier_complete(bar, b.x, nloc, nx); b.st[0] = nloc; b.st[1] = nx; }
    const unsigned old = xb_add(&bar[XB_XSUB(b.x)], 1u);
    const unsigned gen = old / nloc;
    if (old + 1u == (gen + 1u) * nloc) {
      __builtin_amdgcn_fence(__ATOMIC_RELEASE, "agent");
      asm volatile("s_waitcnt vmcnt(0)" ::: "memory");
      const unsigned og = xb_add(&bar[XB_TOP], 1u);
      const unsigned tg = og / nx;
      if (og + 1u == (tg + 1u) * nx) xb_add(&bar[XB_TOPGEN], 1u);
      else XB_SPIN(xb_ld(&bar[XB_TOPGEN]) == tg, bar);
      __builtin_amdgcn_fence(__ATOMIC_ACQUIRE, "agent");
      xb_add(&bar[XB_XGEN(b.x)], 1u);
      asm volatile("s_waitcnt vmcnt(0)" ::: "memory");
    } else {
      XB_SPIN(xb_ld(&bar[XB_XGEN(b.x)]) == gen, bar);
      __builtin_amdgcn_fence(__ATOMIC_ACQUIRE, "agent");
      asm volatile("s_waitcnt vmcnt(0)" ::: "memory");
    }
  }
  __syncthreads();
}

__global__ void __launch_bounds__(NTHREADS, 2) mk_fwd(Params P) {
  extern __shared__ __attribute__((aligned(16))) unsigned char lds_raw[];
  LAS unsigned char* lds = (LAS unsigned char*)lds_raw;
  cg::grid_group grid = cg::this_grid();
  unsigned char* ws = P.ws;
  const int G = gridDim.x, bid = blockIdx.x;
  const int lo = P.ph_lo, hi = P.ph_hi;
#ifndef PHMASK
#define PHMASK 0x7ff
#endif
#define IN(k) (((PHMASK >> (k)) & 1) && lo <= (k) && (k) < hi)
#define GSYNC() xcd_barrier(xbar)
#define SEAM(k) do { if (P.coop && IN(k) && IN((k) + 1)) GSYNC(); } while (0)
  if (threadIdx.x < 4) ((volatile LAS unsigned*)(lds + LDS_ST_OFF))[threadIdx.x] = 0u;
  __syncthreads();
  XcdBarrier xbar; xbar.bar = (unsigned*)(ws + WS_BAR); xbar.x = 0; xbar.st = (volatile LAS unsigned*)(lds + LDS_ST_OFF);
  if (P.coop) xbar = xcd_barrier_post((unsigned*)(ws + WS_BAR), (volatile LAS unsigned*)(lds + LDS_ST_OFF));
  if (P.coop == 2) grid.sync();
  float* modv = (float*)(ws + WS_MODV);
  float* Y = P.out + OUT_Y;

  if (PROBE_PH == 99) { for (int r = 0; r < 10; ++r) GSYNC(); }
  unsigned* p0cnt = (unsigned*)(ws + WS_BAR) + 3584;
  if (IN(0)) {
    phase_prep_gemv(P, lds, modv);
    asm volatile("s_waitcnt vmcnt(0)" ::: "memory");
    __syncthreads();
    if (threadIdx.x == 0) __hip_atomic_fetch_add(p0cnt, 1u, __ATOMIC_RELAXED, __HIP_MEMORY_SCOPE_AGENT);
    phase_prep_rest(P, lds);
  }
  if (IN(1)) {
    if (P.coop && IN(0)) {
      if (threadIdx.x == 0) { unsigned sp = 0;
        while (__hip_atomic_load(p0cnt, __ATOMIC_RELAXED, __HIP_MEMORY_SCOPE_AGENT) < (unsigned)G) { __builtin_amdgcn_s_sleep(2); if (++sp > (1u << 20)) break; }
        __builtin_amdgcn_fence(__ATOMIC_ACQUIRE, "agent");
        asm volatile("s_waitcnt vmcnt(0)" ::: "memory"); }
      __syncthreads();
    }
    phase_modnorm(P.in[I_XP], P.in[I_XS], P.in[I_NA], modv, 0, 1, (bf16_t*)(ws + WS_H));
  }
  SEAM(1);
  if (IN(2)) { for (int rep = 0; rep < REP(2); ++rep) {
    pg8::Gemm g{(const bf16_t*)(ws + WS_H), (const bf16_t*)(ws + WS_WTIN), NTOK, NIN, DM, DM, DM}; pg8::StaticOrder S; S.init(NTOK, NIN, G, bid);
    EpiIn E{ws, P.out, P.in[I_QN], P.in[I_KN], (LAS float*)(lds + LDS_X_OFF)};
    pg8::gemm_phase<EpiIn>(lds, g, S, E);
    if (rep + 1 < REP(2)) GSYNC(); }
    { CvtJob J5{P.in[I_WG], P.in[I_WU], DFF, (bf16_t*)(ws + WS_WTGU), 2048, 0, 16, 2};
      const bool tailwg = (G == 256); const int c0 = tailwg ? bid - 192 : bid, cs = tailwg ? 64 : G;
      if (c0 >= 0) cvt_tiles(J5, c0, 88 * 16, cs, lds); }
  }
  SEAM(2);
#define ATTN_HEAVY(itx) do { const int it_ = (itx); const int qb = it_ & 3, h = (it_ >> 2) & 15, bs = it_ >> 6; \
    const size_t q0 = ((size_t)(NPR + bs * 1024 + qb * 256)) * 4096 + h * 128, k0 = ((size_t)bs * 1536) * 512 + (h >> 2) * 128; \
    att::attn_body((const bf16_t*)(ws + WS_OCAT) + q0, (const bf16_t*)(ws + WS_KALL) + k0, (const bf16_t*)(ws + WS_VALL) + k0, (bf16_t*)(ws + WS_OCAT) + q0, 1536, (char*)lds_raw); __syncthreads(); } while (0)
  if (IN(3)) {
    const bool attn_first = ((bid >> 3) & 1) != 0;
#pragma clang loop unroll(disable)
    for (int pass = 0; pass < 2; ++pass) {
      if ((pass == 0) == attn_first) {
#pragma clang loop unroll(disable)
        for (int it = bid; it < 256; it += G) ATTN_HEAVY(it);
#pragma clang loop unroll(disable)
        for (int id = bid; id < 256; id += G) { const int h = id & 15, b = id >> 4;
          const size_t q0 = ((size_t)(b * 256)) * 4096 + h * 128, k0 = ((size_t)b * 256) * 512 + (h >> 2) * 128;
          att::attn_body((const bf16_t*)(ws + WS_OCAT) + q0, (const bf16_t*)(ws + WS_KP) + k0, (const bf16_t*)(ws + WS_VP) + k0, (bf16_t*)(ws + WS_OCAT) + q0, 256, (char*)lds_raw);
          __syncthreads(); }
      } else {
#pragma clang loop unroll(disable)
        for (int it = bid; it < 768; it += G) ret_state_item(P, it, lds);
        __syncthreads();
      }
    }
  }
  SEAM(3);
  if (IN(4)) {
    const bool attn_first = ((bid >> 3) & 1) != 0;
#pragma clang loop unroll(disable)
    for (int pass = 0; pass < 2; ++pass) {
      if ((pass == 0) == attn_first) {
#pragma clang loop unroll(disable)
        for (int it = 256 + bid; it < 512; it += G) ATTN_HEAVY(it);
      } else {
        if (G == 256) { CvtJob J5{P.in[I_WG], P.in[I_WU], DFF, (bf16_t*)(ws + WS_WTGU), 2048, 0, 16, 2};
          cvt_tiles(J5, 88 * 16 + bid, 88 * 16, G, lds); }
#pragma clang loop unroll(disable)
        for (int it = bid; it < 768; it += G) ret_out_item(P, it, lds, (bf16_t*)(ws + WS_OCAT));
        __syncthreads();
      }
    }
  }
#undef ATTN_HEAVY
  SEAM(4);
  if (IN(5)) {
    for (int rep = 0; rep < REP(5); ++rep) {
    pg8::Gemm g{(const bf16_t*)(ws + WS_OCAT), (const bf16_t*)(ws + WS_WTCAT), NTOK, DM, 2048, 4096, 4096}; pg8::StaticOrder S; S.init(NTOK, DM, G, bid, 192);
    EpiMerge<3> E{(const bf16_t*)(ws + WS_SGA), (const bf16_t*)(ws + WS_SGR), (bf16_t*)(ws + WS_RV)};
    pg8::gemm_phase<EpiMerge<3>, 3>(lds, g, S, E);
    if (rep + 1 < REP(5)) GSYNC(); }
  }
  SEAM(5);
  if (IN(6)) {
    pg8::Gemm g{(const bf16_t*)(ws + WS_RV), (const bf16_t*)(ws + WS_WTOUT), NTOK, DM, DM, DM, DM}; PanelOrder S; S.init(bid);
    EpiResNorm<0> E{P.in[I_XP], P.in[I_XS], Y, modv, 2, P.in[I_NF], (bf16_t*)(ws + WS_RQK), (float*)(ws + WS_SLOT6), (unsigned*)(ws + WS_CNT6), (LAS float*)(lds + LDS_X_OFF)};
    pg8::gemm_phase<EpiResNorm<0>, 3, PanelOrder>(lds, g, S, E);
  }
  if (P.coop && IN(6) && IN(8)) GSYNC();
  if (IN(8)) {
    pg8::Gemm g{(const bf16_t*)(ws + WS_RQK), (const bf16_t*)(ws + WS_WTGU), NTOK, 2 * DFF, DM, DM, DM}; pg8::StaticOrder S; S.init(NTOK, 2 * DFF, G, bid);
    if (G == 256) {
      S.imax = 8;
      { EpiGU<4> E{(bf16_t*)(ws + WS_ACT)}; pg8::gemm_phase<EpiGU<4>>(lds, g, S, E); }
      TailOrder T; T.S = S; T.L0 = 2048; T.ntail = 64; T.c = bid;
      { EpiGU<1> E{(bf16_t*)(ws + WS_ACT)}; pg8::gemm_phase<EpiGU<1>, 1, TailOrder>(lds, g, T, E); }
    } else { EpiGU<4> E{(bf16_t*)(ws + WS_ACT)}; pg8::gemm_phase<EpiGU<4>>(lds, g, S, E); }
    { CvtJob J6{P.in[I_WD], nullptr, 2048, (bf16_t*)(ws + WS_WTD), DFF, 0, 44, 0};
      cvt_tiles(J6, bid, 16 * 44, G, lds); }
  }
  SEAM(8);
  if (IN(9)) {
    pg8::Gemm g{(const bf16_t*)(ws + WS_ACT), (const bf16_t*)(ws + WS_WTD), NTOK, DM, DFF, DFF, DFF}; PanelOrder S; S.init(bid);
    EpiResNorm<1> E{Y, Y + (size_t)NPR * 2048, Y, modv, 5, P.in[I_FN], nullptr, (float*)(ws + WS_SLOT9), (unsigned*)(ws + WS_CNT9), (LAS float*)(lds + LDS_X_OFF)};
    pg8::gemm_phase<EpiResNorm<1>, 3, PanelOrder>(lds, g, S, E);
  }
#undef IN
#undef SEAM
#undef GSYNC
}

extern "C" void kernel_launch(void* const* d_in, const int* in_sizes, int n_in, void* d_out, int out_size, void* d_ws, size_t ws_size, hipStream_t stream) {
  static int grid = 0;
  if (grid == 0) {
    if (n_in != 25 || ws_size < WS_END) { fprintf(stderr, "kernel_launch: n_in %d ws %zu (need %zu)\n", n_in, ws_size, (size_t)WS_END); grid = -1; return; }
    if (hipFuncSetAttribute((const void*)mk_fwd, hipFuncAttributeMaxDynamicSharedMemorySize, LDS_BYTES) != hipSuccess) { fprintf(stderr, "kernel_launch: hipFuncSetAttribute failed\n"); grid = -1; return; }
    int dev = 0, cus = 0, per_cu = 0;
    hipGetDevice(&dev); hipDeviceGetAttribute(&cus, hipDeviceAttributeMultiprocessorCount, dev);
    if (hipOccupancyMaxActiveBlocksPerMultiprocessor(&per_cu, (const void*)mk_fwd, NTHREADS, LDS_BYTES) != hipSuccess || per_cu < 1) { fprintf(stderr, "kernel_launch: occupancy query gave %d\n", per_cu); per_cu = 1; }
    (void)hipGetLastError();
    grid = cus;
    if (cus != 256) { fprintf(stderr, "kernel_launch: built for 256 CUs, got %d\n", cus); grid = -1; return; }
  }
  if (grid < 0) return;
  (void)hipMemsetAsync((char*)d_ws + WS_MODV, 0, WS_SLOT6 - WS_MODV, stream);
  Params p{};
  for (int i = 0; i < 25; ++i) p.in[i] = (const float*)d_in[i];
  p.out = (float*)d_out; p.ws = (unsigned char*)d_ws;
#if MK_MULTI
  for (int ph = 0; ph <= 10; ++ph) { p.ph_lo = ph; p.ph_hi = ph + 1; p.coop = 0;
    hipLaunchKernelGGL(mk_fwd, dim3(grid), dim3(NTHREADS), LDS_BYTES, stream, p); }
#else
  p.ph_lo = 0; p.ph_hi = 11; p.coop = 1;
  void* args[] = {&p};
  hipError_t e = hipLaunchCooperativeKernel((const void*)mk_fwd, dim3(grid), dim3(NTHREADS), args, LDS_BYTES, stream);
  if (e != hipSuccess) fprintf(stderr, "kernel_launch: cooperative launch failed: %s\n", hipGetErrorString(e));
#endif
}
```

```cpp
#include <hip/hip_runtime.h>
#include <hip/hip_cooperative_groups.h>
#include <cstdio>
#include <cstdint>
namespace cg = cooperative_groups;

#ifndef MK_MULTI
#define MK_MULTI 0
#endif

#ifndef PROBE_PH
#define PROBE_PH (-1)
#endif
#define REP(k) ((PROBE_PH == (k)) ? 2 : 1)
#define LAS __attribute__((address_space(3)))
typedef unsigned short bf16_t;
typedef short bf16x8 __attribute__((ext_vector_type(8)));
typedef short s16x4 __attribute__((ext_vector_type(4)));
typedef float f32x4 __attribute__((ext_vector_type(4)));
typedef float f32x8 __attribute__((ext_vector_type(8)));
typedef float f32x16 __attribute__((ext_vector_type(16)));
typedef unsigned u32x4 __attribute__((ext_vector_type(4)));
typedef unsigned u32x2 __attribute__((ext_vector_type(2)));

constexpr int DM = 2048, NTOK = 12288, NPR = 4096, NIN = 13312, DFF = 5632;
constexpr int NTHREADS = 512;
constexpr float EPS = 1e-6f;
constexpr size_t OUT_Y = 0, OUT_NK = 25165824, OUT_NV = 27262976, OUT_RF = 29360128, OUT_RB = 33554432;
constexpr size_t WS_WTIN = 0;
constexpr size_t WS_H    = 54525952;
constexpr size_t WS_SP   = 0;
constexpr size_t WS_WTD  = 0;
constexpr size_t WS_OCAT = 104857600;
constexpr size_t WS_KALL = 205520896;
constexpr size_t WS_VALL = WS_KALL + 12582912;
constexpr size_t WS_KP   = WS_VALL + 12582912;
constexpr size_t WS_VP   = WS_KP + 4194304;
constexpr size_t WS_RQK  = 239075328;
constexpr size_t WS_SGA  = 289406976;
constexpr size_t WS_SGR  = WS_SGA + 50331648;
constexpr size_t WS_RV   = WS_SGR + 50331648;
constexpr size_t WS_ACT  = WS_SGA;
constexpr size_t WS_WTCAT = 440401920;
constexpr size_t WS_WTOUT = WS_WTCAT + 16777216;
constexpr size_t WS_MODV = 465567744;
constexpr size_t WS_ROPE = WS_MODV + 442368;
constexpr size_t WS_BAR  = WS_ROPE + 16384;
constexpr size_t WS_CNT6 = WS_BAR + 16384;
constexpr size_t WS_CNT9 = WS_CNT6 + 16384;
constexpr size_t WS_SLOT6 = WS_CNT9 + 16384;
constexpr size_t WS_SLOT9 = WS_SLOT6 + 393216;
constexpr size_t WS_WTGU = WS_SLOT9 + 393216;
constexpr size_t WS_END  = WS_WTGU + 46137344;

constexpr int LDS_STAGE = 131072;
constexpr int LDS_X_OFF = LDS_STAGE;
constexpr int LDS_ST_OFF = LDS_STAGE + 16384;
constexpr int LDS_BYTES = LDS_ST_OFF + 16;

struct Params {
  const float* in[25];
  float* out; unsigned char* ws;
  int ph_lo, ph_hi, coop, pad;
};
enum { I_XP = 0, I_XS, I_CK, I_CV, I_SF, I_SB, I_C, I_CCTX, I_NA, I_NF, I_WMOD, I_BMOD, I_WIN, I_QN, I_KN, I_DF, I_DB, I_RN, I_WBA, I_WBR, I_WOUT, I_WG, I_WU, I_WD, I_FN };

__device__ __forceinline__ unsigned cvt_pk_bf16(float lo, float hi) { unsigned r; asm volatile("v_cvt_pk_bf16_f32 %0, %1, %2" : "=v"(r) : "v"(lo), "v"(hi)); return r; }
__device__ __forceinline__ float bf_lo(unsigned w) { return __uint_as_float(w << 16); }
__device__ __forceinline__ float bf_hi(unsigned w) { return __uint_as_float(w & 0xffff0000u); }
__device__ __forceinline__ bf16_t f2bf(float f) { unsigned u = __float_as_uint(f); u += 0x7fffu + ((u >> 16) & 1u); return (bf16_t)(u >> 16); }
__device__ __forceinline__ float fast_exp(float x) { return __builtin_amdgcn_exp2f(x * 1.4426950408889634f); }
__device__ __forceinline__ float sigmoidf_(float x) { return __builtin_amdgcn_rcpf(1.0f + fast_exp(-x)); }
__device__ __forceinline__ float siluf_(float x) { return x * sigmoidf_(x); }
__device__ __forceinline__ float wave_sum(float s) {
  s += __shfl_xor(s, 1); s += __shfl_xor(s, 2); s += __shfl_xor(s, 4); s += __shfl_xor(s, 8); s += __shfl_xor(s, 16); s += __shfl_xor(s, 32); return s; }
__device__ __forceinline__ unsigned off_b(unsigned row, unsigned ch) { return 256u * row + 16u * (ch ^ (((row & 3u) << 2) | ((row >> 2) & 3u))); }
__device__ __forceinline__ bf16x8 tr_frag(unsigned a0, unsigned a1) {
  s16x4 lo, hi;
  asm volatile("ds_read_b64_tr_b16 %0, %2\n\tds_read_b64_tr_b16 %1, %3\n\ts_waitcnt lgkmcnt(0)" : "=&v"(lo), "=&v"(hi) : "v"(a0), "v"(a1) : "memory");
  return (bf16x8){lo[0], lo[1], lo[2], lo[3], hi[0], hi[1], hi[2], hi[3]};
}
__device__ __forceinline__ float log2_sigmoid(float x) {
  return -log1pf(__expf(-x)) * 1.4426950408889634f; }

namespace pg8 {
constexpr int BM = 256, BK = 64, HALF = 128, HTB = HALF * BK * 2, STAGE_BYTES = 8 * HTB, NXCD = 8, WGM = 4;
__device__ __forceinline__ int lds_byte(int r, int c) { const int st = (r >> 4) * 2 + (c >> 5), rr = r & 15, cc = c & 31, ob = rr * 64 + cc * 2; return st * 1024 + (ob ^ (((ob >> 9) & 1) << 5)); }
__device__ __forceinline__ void stage_rc(int b, int& R, int& C) { const int st = b / 1024, sb = b % 1024, swz = sb ^ (((sb >> 9) & 1) << 5); R = (st >> 1) * 16 + swz / 64; C = (st & 1) * 32 + (swz % 64) / 2; }
__device__ __forceinline__ int perm32(int rho) { const int n = rho >> 4, i = rho & 15; return 8 * (i >> 2) + 4 * n + (i & 3); }
struct Unit { int pm, pn, seg; };
struct Gemm { const bf16_t* A; const bf16_t* Bt; int M, N, K, lda, ldb; };
struct StaticOrder {
  int nM, nN, nwg, G, c, imax;
  __device__ void init(int M, int N, int G_, int c_, int tm = BM) { nM = M / tm; nN = N / BM; nwg = nM * nN; G = G_; c = c_; imax = 1 << 30; }
  __device__ void unit_of(long L, Unit& u) const {
    int wgid = (int)L; { const int q = nwg / NXCD, r = nwg % NXCD, xcd = wgid % NXCD, off = wgid / NXCD; wgid = (xcd < r ? xcd * (q + 1) : r * (q + 1) + (xcd - r) * q) + off; }
    const int nig = WGM * nN, gid = wgid / nig, fm = gid * WGM, gsz = (nM - fm) < WGM ? (nM - fm) : WGM;
    u.pm = fm + ((wgid % nig) % gsz); u.pn = (wgid % nig) / gsz; }
  __device__ bool next(int i, Unit& u) const {
    const long L = (long)i * G + c; if (L >= nwg || i >= imax) return false;
    int wgid = (int)L; { const int q = nwg / NXCD, r = nwg % NXCD, xcd = wgid % NXCD, off = wgid / NXCD; wgid = (xcd < r ? xcd * (q + 1) : r * (q + 1) + (xcd - r) * q) + off; }
    const int nig = WGM * nN, gid = wgid / nig, fm = gid * WGM, gsz = (nM - fm) < WGM ? (nM - fm) : WGM;
    u.pm = fm + ((wgid % nig) % gsz); u.pn = (wgid % nig) / gsz; return true;
  }
};
template <class Epi, int MB = 4, class Ord = StaticOrder>
__device__ __forceinline__ void gemm_phase(LAS unsigned char* lds, const Gemm g, const Ord& S, const Epi& E) {
  int tid_ = threadIdx.x; asm volatile("" : "+v"(tid_));
  const int tid = tid_, wid = __builtin_amdgcn_readfirstlane(tid >> 6), lane = tid & 63, wr = wid >> 2, wc = wid & 3, fr = lane & 15, fq = lane >> 4;
  const int K = g.K, nt = K / BK;
  unsigned voffA[2], voffB[2];
#pragma unroll
  for (int i = 0; i < 2; ++i) { int R, C; stage_rc(tid * 16 + i * 8192, R, C); const int Rb = Epi::PERM ? ((R & ~31) + perm32(R & 31)) : R;
    voffA[i] = (unsigned)(R * g.lda + C) * 2u; voffB[i] = (unsigned)(Rb * g.ldb + C) * 2u; }
  const size_t kstep = (size_t)(BK * 2);
  const size_t hstepA = (size_t)(32 * MB) * g.lda * 2, hstepB = (size_t)HALF * g.ldb * 2;
  const size_t tstepA = 2 * hstepA, tstepB = 2 * hstepB, segb = (size_t)K * 2;
  const unsigned ldsw = (unsigned)wid * 1024u;
  const int aoff = lds_byte(wr * (16 * MB) + fr, fq * 8), boff = lds_byte(wc * 32 + fr, fq * 8);
#define PG8_SA(b, h) (((b) * 2 + (h)) * HTB)
#define PG8_SB(b, h) ((4 + (b) * 2 + (h)) * HTB)
#define PG8_STAGE(bufoff, gbase, voff) do { _Pragma("unroll") for (int _i = 0; _i < 2; ++_i) \
    __builtin_amdgcn_global_load_lds((const unsigned*)((const char*)(gbase) + (voff)[_i]), (LAS unsigned*)(lds + (bufoff) + ldsw + _i * 8192), 16, 0, 0); } while (0)
#define PG8_STAGEA(bufoff, gbase) do { __builtin_amdgcn_global_load_lds((const unsigned*)((const char*)(gbase) + voffA[0]), (LAS unsigned*)(lds + (bufoff) + ldsw), 16, 0, 0); \
    if (!(MB == 3 && wr == 1)) __builtin_amdgcn_global_load_lds((const unsigned*)((const char*)(gbase) + voffA[1]), (LAS unsigned*)(lds + (bufoff) + ldsw + 8192), 16, 0, 0); } while (0)
#define PG8_LDA(dst, b, h) do { _Pragma("unroll") for (int m = 0; m < MB; ++m) _Pragma("unroll") for (int k = 0; k < 2; ++k) dst[m][k] = *(const LAS bf16x8*)(lds + PG8_SA(b, h) + aoff + m * 2048 + k * 1024); } while (0)
#define PG8_LDB(dst, b, h) do { _Pragma("unroll") for (int n = 0; n < 2; ++n) _Pragma("unroll") for (int k = 0; k < 2; ++k) dst[n][k] = *(const LAS bf16x8*)(lds + PG8_SB(b, h) + boff + n * 2048 + k * 1024); } while (0)
#define PG8_MMA(ai, bj, At, Bt) do { __builtin_amdgcn_s_setprio(1); _Pragma("unroll") for (int m = 0; m < MB; ++m) _Pragma("unroll") for (int n = 0; n < 2; ++n) _Pragma("unroll") for (int k = 0; k < 2; ++k) \
    acc[ai][bj][m][n] = __builtin_amdgcn_mfma_f32_16x16x32_bf16(Bt[n][k], At[m][k], acc[ai][bj][m][n], 0, 0, 0); __builtin_amdgcn_s_setprio(0); } while (0)
#define PG8_WAIT_V(n) asm volatile("s_waitcnt vmcnt(" #n ")" ::: "memory")
#define PG8_WAIT_V6() do { if (MB == 3 && wr == 1) asm volatile("s_waitcnt vmcnt(5)" ::: "memory"); else asm volatile("s_waitcnt vmcnt(6)" ::: "memory"); } while (0)
#define PG8_WAIT_V4() do { if (MB == 3 && wr == 1) asm volatile("s_waitcnt vmcnt(3)" ::: "memory"); else asm volatile("s_waitcnt vmcnt(4)" ::: "memory"); } while (0)
#define PG8_WAIT_L(n) asm volatile("s_waitcnt lgkmcnt(" #n ")" ::: "memory")
#define PG8_BAR __builtin_amdgcn_s_barrier()
#define PG8_SCHED __builtin_amdgcn_sched_barrier(0)
  Unit cur, nxt; int ui = 0;
  if (!S.next(0, cur)) return;
  cur.seg = 0;
  f32x4 acc[2][2][MB][2];
#pragma unroll
  for (int a = 0; a < 2; ++a)
#pragma unroll
    for (int b = 0; b < 2; ++b)
#pragma unroll
      for (int m = 0; m < MB; ++m)
#pragma unroll
        for (int n = 0; n < 2; ++n) acc[a][b][m][n] = (f32x4){0.f, 0.f, 0.f, 0.f};
  bf16x8 At[MB][2], B0[2][2], B1[2][2];
  const char* cA = (const char*)g.A + (size_t)cur.pm * tstepA + (Epi::KSPLIT ? (size_t)(cur.pn & 1) * segb : 0); const char* cB = (const char*)g.Bt + (size_t)(Epi::KSPLIT ? cur.pn >> 1 : cur.pn) * tstepB + (Epi::KSPLIT ? (size_t)(cur.pn & 1) * segb : 0);
  PG8_STAGE(PG8_SB(0, 0), cB, voffB); PG8_STAGEA(PG8_SA(0, 0), cA); PG8_STAGE(PG8_SB(0, 1), cB + hstepB, voffB); PG8_STAGEA(PG8_SA(0, 1), cA + hstepA);
  if (wr == 1) PG8_BAR;
  PG8_WAIT_V4(); PG8_BAR;
  PG8_STAGE(PG8_SB(1, 0), cB + kstep, voffB); PG8_STAGEA(PG8_SA(1, 0), cA + kstep); PG8_STAGE(PG8_SB(1, 1), cB + hstepB + kstep, voffB);
  PG8_WAIT_V6(); PG8_BAR;
  for (;;) {
    bool has_next;
    if (Epi::NSEG > 1 && cur.seg + 1 < Epi::NSEG) { nxt = cur; nxt.seg = cur.seg + 1; has_next = true; }
    else { has_next = S.next(ui + 1, nxt); nxt.seg = 0; }
    const size_t nko = Epi::KSPLIT ? (size_t)(nxt.pn & 1) * segb : (size_t)nxt.seg * segb;
    const char* nA = has_next ? (const char*)g.A + (size_t)nxt.pm * tstepA + nko : cA; const char* nB = has_next ? (const char*)g.Bt + (size_t)(Epi::KSPLIT ? nxt.pn >> 1 : nxt.pn) * tstepB + nko : cB;
    for (int t = 0; t < nt; t += 2) {
      const bool last = (t == nt - 2);
      const char* a1 = cA + (size_t)(t + 1) * kstep;
      const char* a2 = last ? nA : cA + (size_t)(t + 2) * kstep; const char* b2 = last ? nB : cB + (size_t)(t + 2) * kstep;
      const char* a3 = a2 + kstep; const char* b3 = b2 + kstep;
      PG8_LDB(B0, 0, 0); PG8_SCHED; PG8_LDA(At, 0, 0); PG8_STAGEA(PG8_SA(1, 1), a1 + hstepA);
      PG8_WAIT_L(8); PG8_BAR; PG8_WAIT_L(0); PG8_MMA(0, 0, At, B0); PG8_BAR; PG8_SCHED;
      PG8_LDB(B1, 0, 1); PG8_STAGE(PG8_SB(0, 0), b2, voffB);
      PG8_BAR; PG8_WAIT_L(0); PG8_MMA(0, 1, At, B1); PG8_BAR;
      PG8_LDA(At, 0, 1); PG8_STAGEA(PG8_SA(0, 0), a2);
      PG8_BAR; PG8_WAIT_L(0); PG8_MMA(1, 0, At, B0); PG8_BAR; PG8_SCHED;
      PG8_STAGE(PG8_SB(0, 1), b2 + hstepB, voffB);
      PG8_WAIT_V6(); PG8_BAR; PG8_MMA(1, 1, At, B1); PG8_BAR;
      PG8_LDB(B0, 1, 0); PG8_SCHED; PG8_LDA(At, 1, 0); PG8_STAGEA(PG8_SA(0, 1), a2 + hstepA);
      PG8_WAIT_L(8); PG8_BAR; PG8_WAIT_L(0); PG8_MMA(0, 0, At, B0); PG8_BAR; PG8_SCHED;
      PG8_LDB(B1, 1, 1); PG8_STAGE(PG8_SB(1, 0), b3, voffB);
      PG8_BAR; PG8_WAIT_L(0); PG8_MMA(0, 1, At, B1); PG8_BAR;
      PG8_LDA(At, 1, 1); PG8_STAGEA(PG8_SA(1, 0), a3);
      PG8_BAR; PG8_WAIT_L(0); PG8_MMA(1, 0, At, B0); PG8_BAR; PG8_SCHED;
      PG8_STAGE(PG8_SB(1, 1), b3 + hstepB, voffB);
      PG8_WAIT_V6(); PG8_BAR; PG8_MMA(1, 1, At, B1); PG8_BAR;
    }
    E(acc, cur, wr, wc, fr, fq);
    if (!has_next) break;
    if (Epi::NSEG == 1 || nxt.seg == 0) {
#pragma unroll
    for (int a = 0; a < 2; ++a)
#pragma unroll
      for (int b = 0; b < 2; ++b)
#pragma unroll
        for (int m = 0; m < MB; ++m)
#pragma unroll
          for (int n = 0; n < 2; ++n) acc[a][b][m][n] = (f32x4){0.f, 0.f, 0.f, 0.f};
    ++ui; }
    cur = nxt; cA = nA; cB = nB;
  }
  PG8_WAIT_V(0);
  if (wr == 0) PG8_BAR;
  PG8_BAR;
#undef PG8_SA
#undef PG8_SB
#undef PG8_STAGE
#undef PG8_STAGEA
#undef PG8_WAIT_V6
#undef PG8_WAIT_V4
#undef PG8_LDA
#undef PG8_LDB
#undef PG8_MMA
#undef PG8_WAIT_V
#undef PG8_WAIT_L
#undef PG8_BAR
#undef PG8_SCHED
}
}
using pg8::Unit;

__device__ __forceinline__ u32x4 pack8(f32x4 a, f32x4 b) { u32x4 w; w.x = cvt_pk_bf16(a[0], a[1]); w.y = cvt_pk_bf16(a[2], a[3]); w.z = cvt_pk_bf16(b[0], b[1]); w.w = cvt_pk_bf16(b[2], b[3]); return w; }

struct EpiIn {
  static constexpr bool PERM = true, KSPLIT = false; static constexpr int NSEG = 1;
  unsigned char* ws; float* out; const float* qnorm; const float* knorm; LAS float* X;
  __device__ __forceinline__ void operator()(f32x4 (&acc)[2][2][4][2], const Unit& u, int wr, int wc, int fr, int fq) const {
    const int pn = u.pn, pm = u.pm; const bool sample = pm >= 16;
    if (pn < 10) {
      const bool isq = pn < 8; const float* gw = isq ? qnorm : knorm;
      const int half = wc >> 1, i0 = (wc & 1) * 16 + fq * 4;
      const f32x4 g1 = *(const f32x4*)(gw + half * 64 + i0), g2 = *(const f32x4*)(gw + half * 64 + 32 + i0);
#pragma unroll
      for (int ai = 0; ai < 2; ++ai)
#pragma unroll
        for (int m = 0; m < 4; ++m)
#pragma unroll
          for (int bj = 0; bj < 2; ++bj) {
            const f32x4 a = acc[ai][bj][m][0], b = acc[ai][bj][m][1];
            float s = (a[0] * a[0] + a[1] * a[1]) + (a[2] * a[2] + a[3] * a[3]) + (b[0] * b[0] + b[1] * b[1]) + (b[2] * b[2] + b[3] * b[3]);
            s += __shfl_xor(s, 16); s += __shfl_xor(s, 32);
            if (fq == 0) X[(ai * 128 + wr * 64 + m * 16 + fr) * 8 + bj * 4 + wc] = s;
          }
      asm volatile("s_waitcnt lgkmcnt(0)" ::: "memory"); __builtin_amdgcn_s_barrier(); asm volatile("" ::: "memory");
      const float* ropeC = (const float*)(ws + WS_ROPE); const float* ropeS = ropeC + 2048;
#pragma unroll
      for (int ai = 0; ai < 2; ++ai)
#pragma unroll
        for (int m = 0; m < 4; ++m) {
          const int rl = ai * 128 + wr * 64 + m * 16 + fr, row = pm * 256 + rl;
          const int t = (row - NPR) & 1023;
          f32x4 cs = (f32x4){1.f, 1.f, 1.f, 1.f}, sn = (f32x4){0.f, 0.f, 0.f, 0.f};
          if (sample) { const int pos = half ? (t & 63) : (t >> 6); cs = *(const f32x4*)(ropeC + pos * 32 + i0); sn = *(const f32x4*)(ropeS + pos * 32 + i0); }
#pragma unroll
          for (int bj = 0; bj < 2; ++bj) {
            const f32x4 xs = *(const LAS f32x4*)(X + rl * 8 + bj * 4);
            const float rstd = __builtin_amdgcn_rsqf(((xs[0] + xs[1]) + (xs[2] + xs[3])) * (1.0f / 128.0f) + EPS);
            const f32x4 x1 = acc[ai][bj][m][0] * rstd * g1, x2 = acc[ai][bj][m][1] * rstd * g2;
            const f32x4 o1 = x1 * cs - x2 * sn, o2 = x2 * cs + x1 * sn;
            const u32x4 w = pack8(o1, o2);
            const int cin = bj * 128 + wc * 32 + fq * 8;
            if (isq) { *(u32x4*)((bf16_t*)(ws + WS_OCAT) + (size_t)row * 4096 + pn * 256 + cin) = w; }
            else {
              const int kvh = (pn - 8) * 2 + bj, cc = kvh * 128 + wc * 32 + fq * 8;
              if (!sample) {
                *(u32x4*)((bf16_t*)(ws + WS_KP) + (size_t)row * 512 + cc) = w;
                float* ok = out + OUT_NK + (size_t)row * 512 + kvh * 128 + half * 64 + i0;
                *(f32x4*)ok = o1; *(f32x4*)(ok + 32) = o2;
              } else {
                const int bs = (pm - 16) >> 2;
                *(u32x4*)((bf16_t*)(ws + WS_KALL) + ((size_t)bs * 1536 + 512 + t) * 512 + cc) = w;
              }
            }
          }
        }
    } else if (pn < 12) {
#pragma unroll
      for (int ai = 0; ai < 2; ++ai)
#pragma unroll
        for (int m = 0; m < 4; ++m) {
          const int rl = ai * 128 + wr * 64 + m * 16 + fr, row = pm * 256 + rl; const int t = (row - NPR) & 1023;
#pragma unroll
          for (int bj = 0; bj < 2; ++bj) {
            const f32x4 a = acc[ai][bj][m][0], b = acc[ai][bj][m][1]; const u32x4 w = pack8(a, b);
            const int kvh = (pn - 10) * 2 + bj, cc = kvh * 128 + wc * 32 + fq * 8;
            if (!sample) {
              *(u32x4*)((bf16_t*)(ws + WS_VP) + (size_t)row * 512 + cc) = w;
              float* ov = out + OUT_NV + (size_t)row * 512 + cc; *(f32x4*)ov = a; *(f32x4*)(ov + 4) = b;
            } else {
              const int bs = (pm - 16) >> 2;
              *(u32x4*)((bf16_t*)(ws + WS_VALL) + ((size_t)bs * 1536 + 512 + t) * 512 + cc) = w;
            }
          }
        }
    } else {
      bf16_t* base; int ld, col0, act;
      if (pn < 20) { base = (bf16_t*)(ws + WS_RQK); ld = 2048; col0 = (pn - 12) * 256; act = 0; }
      else if (pn < 28) { base = (bf16_t*)(ws + WS_RV); ld = 2048; col0 = (pn - 20) * 256; act = 0; }
      else if (pn < 36) { base = (bf16_t*)(ws + WS_OCAT); ld = 4096; col0 = 2048 + (pn - 28) * 256; act = 1; }
      else if (pn < 44) { base = (bf16_t*)(ws + WS_SGA); ld = 2048; col0 = (pn - 36) * 256; act = 2; }
      else { base = (bf16_t*)(ws + WS_SGR); ld = 2048; col0 = (pn - 44) * 256; act = 2; }
#pragma unroll
      for (int ai = 0; ai < 2; ++ai)
#pragma unroll
        for (int m = 0; m < 4; ++m) {
          const int row = pm * 256 + ai * 128 + wr * 64 + m * 16 + fr;
          bf16_t* rowp = base + (size_t)row * ld + col0 + wc * 32 + fq * 8;
#pragma unroll
          for (int bj = 0; bj < 2; ++bj) {
            f32x4 a = acc[ai][bj][m][0], b = acc[ai][bj][m][1];
            if (act == 1) {
#pragma unroll
              for (int j = 0; j < 4; ++j) { a[j] = siluf_(a[j]); b[j] = siluf_(b[j]); } }
            else if (act == 2) {
#pragma unroll
              for (int j = 0; j < 4; ++j) { a[j] = sigmoidf_(a[j]); b[j] = sigmoidf_(b[j]); } }
            *(u32x4*)(rowp + bj * 128) = pack8(a, b);
          }
        }
    }
  }
};

template <int MB> struct EpiMerge {
  static constexpr bool PERM = true, KSPLIT = false; static constexpr int NSEG = 2;
  const bf16_t* sga; const bf16_t* sgr; bf16_t* merged;
  __device__ __forceinline__ void mid(f32x4 (&acc)[2][2][MB][2], const Unit& u, int wr, int wc, int fr, int fq) const {
#pragma unroll
    for (int ai = 0; ai < 2; ++ai)
#pragma unroll
      for (int m = 0; m < MB; ++m) {
        const int row = u.pm * (64 * MB) + ai * (32 * MB) + wr * (16 * MB) + m * 16 + fr;
#pragma unroll
        for (int bj = 0; bj < 2; ++bj) {
          const size_t off = (size_t)row * 2048 + u.pn * 256 + bj * 128 + wc * 32 + fq * 8;
          const u32x4 a = *(const u32x4*)(sga + off), r = *(const u32x4*)(sgr + off);
          f32x4 q0, q1;
          q0[0] = bf_lo(a.x) * __builtin_amdgcn_rcpf(bf_lo(r.x)); q0[1] = bf_hi(a.x) * __builtin_amdgcn_rcpf(bf_hi(r.x));
          q0[2] = bf_lo(a.y) * __builtin_amdgcn_rcpf(bf_lo(r.y)); q0[3] = bf_hi(a.y) * __builtin_amdgcn_rcpf(bf_hi(r.y));
          q1[0] = bf_lo(a.z) * __builtin_amdgcn_rcpf(bf_lo(r.z)); q1[1] = bf_hi(a.z) * __builtin_amdgcn_rcpf(bf_hi(r.z));
          q1[2] = bf_lo(a.w) * __builtin_amdgcn_rcpf(bf_lo(r.w)); q1[3] = bf_hi(a.w) * __builtin_amdgcn_rcpf(bf_hi(r.w));
          acc[ai][bj][m][0] *= q0; acc[ai][bj][m][1] *= q1;
        }
      }
  }
  __device__ __forceinline__ void operator()(f32x4 (&acc)[2][2][MB][2], const Unit& u, int wr, int wc, int fr, int fq) const {
    if (u.seg == 0) { mid(acc, u, wr, wc, fr, fq); return; }
#pragma unroll
    for (int ai = 0; ai < 2; ++ai)
#pragma unroll
      for (int m = 0; m < MB; ++m) {
        const int row = u.pm * (64 * MB) + ai * (32 * MB) + wr * (16 * MB) + m * 16 + fr;
#pragma unroll
        for (int bj = 0; bj < 2; ++bj) {
          const size_t off = (size_t)row * 2048 + u.pn * 256 + bj * 128 + wc * 32 + fq * 8;
          const u32x4 r = *(const u32x4*)(sgr + off);
          const f32x4 r0 = (f32x4){bf_lo(r.x), bf_hi(r.x), bf_lo(r.y), bf_hi(r.y)}, r1 = (f32x4){bf_lo(r.z), bf_hi(r.z), bf_lo(r.w), bf_hi(r.w)};
          *(u32x4*)(merged + off) = pack8(acc[ai][bj][m][0] * r0, acc[ai][bj][m][1] * r1);
        }
      }
  }
};

template <int MB> struct EpiRes {
  static constexpr bool PERM = false, KSPLIT = false; static constexpr int NSEG = 1;
  const float* xa; const float* xb; float* Y; const float* gate;
  __device__ __forceinline__ void operator()(f32x4 (&acc)[2][2][MB][2], const Unit& u, int wr, int wc, int fr, int fq) const {
    const int cbase = u.pn * 256 + wc * 32 + fq * 4;
#pragma unroll
    for (int ai = 0; ai < 2; ++ai)
#pragma unroll
      for (int m = 0; m < MB; ++m) {
        const int row = u.pm * (64 * MB) + ai * (32 * MB) + wr * (16 * MB) + m * 16 + fr;
        const int mi = row < NPR ? 8 : (row - NPR) >> 10;
        const float* gp = gate + (size_t)mi * 12288 + cbase;
        const float* xr = (row < NPR ? xa + (size_t)row * 2048 : xb + (size_t)(row - NPR) * 2048) + cbase;
        float* yr = Y + (size_t)row * 2048 + cbase;
#pragma unroll
        for (int bj = 0; bj < 2; ++bj)
#pragma unroll
          for (int n = 0; n < 2; ++n) { const f32x4 xv = *(const f32x4*)(xr + bj * 128 + n * 16), gv = *(const f32x4*)(gp + bj * 128 + n * 16);
            *(f32x4*)(yr + bj * 128 + n * 16) = xv + gv * acc[ai][bj][m][n]; }
        asm volatile("" ::: "memory");
      }
  }
};


struct PanelOrder {
  int c;
  __device__ void init(int c_) { c = c_; }
  __device__ bool next(int i, Unit& u) const { if (i >= 2) return false; const int j = c >> 3; u.pm = i * 32 + (c & 7) * 4 + (j >> 3); u.pn = j & 7; return true; }
};
template <int MODE> struct EpiResNorm {
  static constexpr bool PERM = false, KSPLIT = false; static constexpr int NSEG = 1;
  const float* xa; const float* xb; float* Y; const float* modv; int gidx; const float* normw; bf16_t* H; float* slots; unsigned* cnt; LAS float* X;
  __device__ __forceinline__ void operator()(f32x4 (&acc)[2][2][3][2], const Unit& u, int wr, int wc, int fr, int fq) const {
    int lane = threadIdx.x & 63; asm volatile("" : "+v"(lane));
    const int cbase = u.pn * 256 + wc * 32 + fq * 4;
#pragma unroll
    for (int ai = 0; ai < 2; ++ai)
#pragma unroll
      for (int m = 0; m < 3; ++m) {
        const int rl = ai * 96 + wr * 48 + m * 16 + fr, row = u.pm * 192 + rl;
        const int mi = row < NPR ? 8 : (row - NPR) >> 10;
        const float* gp = modv + (size_t)mi * 12288 + gidx * 2048 + cbase;
        const float* xr = (row < NPR ? xa + (size_t)row * 2048 : xb + (size_t)(row - NPR) * 2048) + cbase;
        float ss = 0.f;
#pragma unroll
        for (int bj = 0; bj < 2; ++bj)
#pragma unroll
          for (int n = 0; n < 2; ++n) { const f32x4 xv = *(const f32x4*)(xr + bj * 128 + n * 16), gv = *(const f32x4*)(gp + bj * 128 + n * 16);
            const f32x4 v = xv + gv * acc[ai][bj][m][n]; acc[ai][bj][m][n] = v;
            if (MODE == 0) *(f32x4*)(Y + (size_t)row * 2048 + cbase + bj * 128 + n * 16) = v;
            ss += (v[0] * v[0] + v[1] * v[1]) + (v[2] * v[2] + v[3] * v[3]); }
        ss += __shfl_xor(ss, 16); ss += __shfl_xor(ss, 32);
        if (fq == 0) X[rl * 4 + wc] = ss;
        if (m == 2) asm volatile("" ::: "memory");
      }
    asm volatile("s_waitcnt lgkmcnt(0)" ::: "memory"); __builtin_amdgcn_s_barrier(); asm volatile("" ::: "memory");
    if (wc < 2) {
      const int t = wc * 64 + lane;
      if (t < 96) { const int rl = (t / 48) * 96 + wr * 48 + (t % 48);
        const f32x4 p = *(const LAS f32x4*)(X + rl * 4);
        __hip_atomic_store(slots + ((size_t)(u.pm * 192 + rl)) * 8 + u.pn, (p[0] + p[1]) + (p[2] + p[3]), __ATOMIC_RELAXED, __HIP_MEMORY_SCOPE_AGENT); }
      asm volatile("s_waitcnt vmcnt(0)" ::: "memory");
      if (lane == 0) __hip_atomic_fetch_add(cnt + 64 * u.pm, 1u, __ATOMIC_RELAXED, __HIP_MEMORY_SCOPE_AGENT);
    }
    asm volatile("" ::: "memory"); __builtin_amdgcn_s_barrier(); asm volatile("" ::: "memory");
    if (wc == 0) { unsigned sp = 0;
      while ((unsigned)__builtin_amdgcn_readfirstlane(__hip_atomic_load(cnt + 64 * u.pm, __ATOMIC_RELAXED, __HIP_MEMORY_SCOPE_AGENT)) < 32u) { __builtin_amdgcn_s_sleep(2); if (++sp > (1u << 20)) break; }
      __builtin_amdgcn_fence(__ATOMIC_ACQUIRE, "agent");
      asm volatile("s_waitcnt vmcnt(0)" ::: "memory"); }
    asm volatile("" ::: "memory"); __builtin_amdgcn_s_barrier(); asm volatile("" ::: "memory");
#pragma unroll
    for (int ai = 0; ai < 2; ++ai)
#pragma unroll
      for (int m = 0; m < 3; ++m) {
        const int rl = ai * 96 + wr * 48 + m * 16 + fr, row = u.pm * 192 + rl;
        const unsigned long long* sl = (const unsigned long long*)(slots + (size_t)row * 8);
        float ssq = 0.f;
#pragma unroll
        for (int q = 0; q < 4; ++q) { const unsigned long long w2 = __hip_atomic_load(sl + q, __ATOMIC_RELAXED, __HIP_MEMORY_SCOPE_AGENT); ssq += __uint_as_float((unsigned)w2) + __uint_as_float((unsigned)(w2 >> 32)); }
        const float rstd = 1.0f / sqrtf(ssq * (1.0f / 2048.0f) + EPS);
        if (MODE == 0) {
          const int mi = row < NPR ? 8 : (row - NPR) >> 10; const float* mv = modv + (size_t)mi * 12288 + cbase;
#pragma unroll
          for (int bj = 0; bj < 2; ++bj)
#pragma unroll
            for (int n = 0; n < 2; ++n) { const int co = bj * 128 + n * 16;
              const f32x4 w = *(const f32x4*)(normw + cbase + co), sc = *(const f32x4*)(mv + 4 * 2048 + co), sh = *(const f32x4*)(mv + 3 * 2048 + co);
              const f32x4 y = acc[ai][bj][m][n] * rstd * w * (1.0f + sc) + sh;
              u32x2 o; o.x = cvt_pk_bf16(y[0], y[1]); o.y = cvt_pk_bf16(y[2], y[3]);
              *(u32x2*)(H + (size_t)row * 2048 + cbase + co) = o; }
        } else {
#pragma unroll
          for (int bj = 0; bj < 2; ++bj)
#pragma unroll
            for (int n = 0; n < 2; ++n) { const int co = bj * 128 + n * 16;
              const f32x4 w = *(const f32x4*)(normw + cbase + co);
              *(f32x4*)(Y + (size_t)row * 2048 + cbase + co) = acc[ai][bj][m][n] * rstd * w; }
        }
        if (m == 2) asm volatile("" ::: "memory");
      }
  }
};

struct TailOrder {
  pg8::StaticOrder S; int L0, ntail, c;
  __device__ bool next(int i, Unit& u) const { if (i != 0 || (c >> 2) >= ntail) return false; S.unit_of(L0 + (c >> 2), u); u.pm = u.pm * 4 + (c & 3); return true; }
};
template <int MB> struct EpiGU {
  static constexpr bool PERM = true, KSPLIT = false; static constexpr int NSEG = 1;
  bf16_t* act;
  __device__ __forceinline__ void operator()(f32x4 (&acc)[2][2][MB][2], const Unit& u, int wr, int wc, int fr, int fq) const {
#pragma unroll
    for (int ai = 0; ai < 2; ++ai)
#pragma unroll
      for (int m = 0; m < MB; ++m) {
        const int row = u.pm * (64 * MB) + ai * (32 * MB) + wr * (16 * MB) + m * 16 + fr;
        bf16_t* rp = act + (size_t)row * DFF + u.pn * 128 + wc * 16 + fq * 4;
#pragma unroll
        for (int bj = 0; bj < 2; ++bj) {
          const f32x4 g = acc[ai][bj][m][0], up = acc[ai][bj][m][1];
          u32x2 w; w.x = cvt_pk_bf16(siluf_(g[0]) * up[0], siluf_(g[1]) * up[1]); w.y = cvt_pk_bf16(siluf_(g[2]) * up[2], siluf_(g[3]) * up[3]);
          *(u32x2*)(rp + bj * 64) = w;
        }
      }
  }
};

struct CvtJob { const float* src; const float* src2; int ldsrc; bf16_t* dst; int lddst; int dcol0; int nKt; int mode; };
__device__ __forceinline__ void cvt_addr(const CvtJob& J, int tile, int e, int kk, const float*& p, int& rloc) {
  const int Rt = tile / J.nKt, Kt = tile % J.nKt;
  int scol; const float* sp = J.src;
  if (J.mode == 2) { const int n = e >> 6, cc = e & 63; scol = Rt * 64 + cc; sp = n ? J.src2 : J.src; rloc = 32 * (cc >> 4) + 8 * ((cc >> 2) & 3) + 4 * n + (cc & 3); }
  else { scol = Rt * 128 + e; rloc = e;
    if (J.mode == 1 && Rt < 20) { const int half = e >> 6, n = (e >> 5) & 1, i = e & 31; rloc = 32 * (half * 2 + (i >> 4)) + 8 * ((i >> 2) & 3) + 4 * n + (i & 3); } }
  p = sp + (size_t)(Kt * 128 + kk) * J.ldsrc + scol;
}
__device__ __forceinline__ void cvt_tiles(const CvtJob& J, int t0, int tend, int stride, LAS unsigned char* lds) {
  if (t0 >= tend) return;
  int tid_ = threadIdx.x; asm volatile("" : "+v"(tid_));
  const int tid = tid_, e = tid & 127, kk = tid >> 7;
  const float* p; int rloc; float v[32], vn[32];
  cvt_addr(J, t0, e, kk, p, rloc);
#pragma unroll
  for (int i = 0; i < 32; ++i) v[i] = __builtin_nontemporal_load(p + (size_t)(4 * i) * J.ldsrc);
  int buf = 0;
  __syncthreads();
  for (int t = t0; t < tend; t += stride) {
    LAS bf16_t* T = (LAS bf16_t*)(lds + buf * (128 * 136 * 2));
#pragma unroll
    for (int i = 0; i < 32; ++i) T[rloc * 136 + kk + 4 * i] = f2bf(v[i]);
    const int tn = t + stride; int rlocn = rloc;
    if (tn < tend) { const float* pn; cvt_addr(J, tn, e, kk, pn, rlocn);
#pragma unroll
      for (int i = 0; i < 32; ++i) vn[i] = __builtin_nontemporal_load(pn + (size_t)(4 * i) * J.ldsrc); }
    __syncthreads();
    const int Rt = t / J.nKt, Kt = t % J.nKt;
#pragma unroll
    for (int it = 0; it < 4; ++it) { const int ch = tid + 512 * it, row = ch >> 4, c8 = ch & 15;
      const u32x4 w = *(const LAS u32x4*)(T + row * 136 + c8 * 8);
      *(u32x4*)(J.dst + (size_t)(Rt * 128 + row) * J.lddst + J.dcol0 + Kt * 128 + c8 * 8) = w; }
    if (tn < tend) {
#pragma unroll
      for (int i = 0; i < 32; ++i) v[i] = vn[i]; }
    rloc = rlocn; buf ^= 1;
  }
  __syncthreads();
}

__device__ __forceinline__ void phase_prep_gemv(const Params& P, LAS unsigned char* lds, float* modv) {
  const int tid = threadIdx.x, G = gridDim.x, bid = blockIdx.x;
  {
    LAS float* Sv = (LAS float*)lds;
    LAS float* Rd = (LAS float*)(lds + 8192);
    const float* wmod = P.in[I_WMOD];
    for (int item = bid; item < 768; item += G) {
      const int cb = item % 48, ks = item / 48;
      for (int idx = tid; idx < 9 * 128; idx += NTHREADS) { const int vi = idx >> 7, kk = idx & 127;
        const float x = vi < 8 ? P.in[I_C][vi * 2048 + ks * 128 + kk] : P.in[I_CCTX][ks * 128 + kk]; Sv[idx] = siluf_(x); }
      __syncthreads();
      const int lane = tid & 63, wave = tid >> 6, col = cb * 256 + lane * 4;
      f32x4 a[9];
#pragma unroll
      for (int vi = 0; vi < 9; ++vi) a[vi] = (f32x4){0.f, 0.f, 0.f, 0.f};
#pragma unroll 4
      for (int r = 0; r < 16; ++r) { const int k = wave + 8 * r; const f32x4 w = __builtin_nontemporal_load((const f32x4*)(wmod + (size_t)(ks * 128 + k) * 12288 + col));
#pragma unroll
        for (int vi = 0; vi < 9; ++vi) a[vi] += Sv[vi * 128 + k] * w; }
#pragma unroll
      for (int vi = 0; vi < 9; ++vi) *(LAS f32x4*)(Rd + (wave * 9 + vi) * 256 + lane * 4) = a[vi];
      __syncthreads();
      for (int idx = tid; idx < 9 * 256; idx += NTHREADS) { const int vi = idx >> 8, c = idx & 255; float s = 0.f;
#pragma unroll
        for (int w = 0; w < 8; ++w) s += Rd[(w * 9 + vi) * 256 + c];
        if (ks == 0) s += P.in[I_BMOD][cb * 256 + c];
        atomicAdd(modv + vi * 12288 + cb * 256 + c, s); }
      __syncthreads();
    }
  }
}
__device__ __forceinline__ void phase_prep_rest(const Params& P, LAS unsigned char* lds) {
  const int tid = threadIdx.x, G = gridDim.x, bid = blockIdx.x;
  unsigned char* ws = P.ws;
  {
    CvtJob J1{P.in[I_WIN], nullptr, NIN, (bf16_t*)(ws + WS_WTIN), 2048, 0, 16, 1};
    cvt_tiles(J1, bid, 104 * 16, G, lds);
    CvtJob J2{P.in[I_WBA], nullptr, 2048, (bf16_t*)(ws + WS_WTCAT), 4096, 0, 16, 0};
    cvt_tiles(J2, bid, 16 * 16, G, lds);
    CvtJob J3{P.in[I_WBR], nullptr, 2048, (bf16_t*)(ws + WS_WTCAT), 4096, 2048, 16, 0};
    cvt_tiles(J3, bid, 16 * 16, G, lds);
    CvtJob J4{P.in[I_WOUT], nullptr, 2048, (bf16_t*)(ws + WS_WTOUT), 2048, 0, 16, 0};
    cvt_tiles(J4, bid, 16 * 16, G, lds);
  }
  {
    const float* ck = P.in[I_CK]; const float* cv = P.in[I_CV];
    bf16_t* kall = (bf16_t*)(ws + WS_KALL); bf16_t* vall = (bf16_t*)(ws + WS_VALL);
    for (int idx = bid * NTHREADS + tid; idx < 262144; idx += G * NTHREADS) {
      const int pc = idx & 15, kvh = (idx >> 4) & 3, t = (idx >> 6) & 511, bs = idx >> 15;
      const size_t src = ((size_t)(bs * 512 + t) * 4 + kvh) * 128, dst = ((size_t)bs * 1536 + t) * 512 + kvh * 128 + pc * 8;
      const int wc = pc >> 2, fq = pc & 3, half = wc >> 1, i0 = (wc & 1) * 16 + fq * 4;
      const f32x4 k1 = *(const f32x4*)(ck + src + half * 64 + i0), k2 = *(const f32x4*)(ck + src + half * 64 + 32 + i0);
      *(u32x4*)(kall + dst) = pack8(k1, k2);
      const f32x4 v1 = *(const f32x4*)(cv + src + pc * 8), v2 = *(const f32x4*)(cv + src + pc * 8 + 4);
      *(u32x4*)(vall + dst) = pack8(v1, v2);
    }
  }
  {
    float* ropeC = (float*)(ws + WS_ROPE); float* ropeS = ropeC + 2048;
    for (int idx = bid * NTHREADS + tid; idx < 2048; idx += G * NTHREADS) {
      const int pos = idx >> 5, i = idx & 31;
      const float inv = __builtin_amdgcn_exp2f(-(float)i * (13.287712379549449f / 32.0f));
      float rev = (float)pos * inv * 0.15915494309189535f; rev -= floorf(rev);
      ropeC[idx] = __builtin_amdgcn_cosf(rev); ropeS[idx] = __builtin_amdgcn_sinf(rev);
    }
  }
}

__device__ __forceinline__ void phase_modnorm(const float* xa, const float* xb, const float* normw, const float* modv, int sh_idx, int sc_idx, bf16_t* outp) {
  const int lane = threadIdx.x & 63, wave = threadIdx.x >> 6;
  for (int row = blockIdx.x * 8 + wave; row < NTOK; row += gridDim.x * 8) {
    const float* xr = row < NPR ? xa + (size_t)row * 2048 : xb + (size_t)(row - NPR) * 2048;
    f32x4 v[8]; float ss = 0.f;
#pragma unroll
    for (int i = 0; i < 8; ++i) { v[i] = *(const f32x4*)(xr + i * 256 + lane * 4); ss += (v[i][0] * v[i][0] + v[i][1] * v[i][1]) + (v[i][2] * v[i][2] + v[i][3] * v[i][3]); }
    ss = wave_sum(ss);
    const float rstd = 1.0f / sqrtf(ss * (1.0f / 2048.0f) + EPS);
    const int mi = row < NPR ? 8 : (row - NPR) >> 10; const float* mv = modv + (size_t)mi * 12288;
#pragma unroll
    for (int i = 0; i < 8; ++i) { const int c = i * 256 + lane * 4;
      const f32x4 w = *(const f32x4*)(normw + c), sc = *(const f32x4*)(mv + sc_idx * 2048 + c), sh = *(const f32x4*)(mv + sh_idx * 2048 + c);
      const f32x4 y = v[i] * rstd * w * (1.0f + sc) + sh;
      u32x2 o; o.x = cvt_pk_bf16(y[0], y[1]); o.y = cvt_pk_bf16(y[2], y[3]);
      *(u32x2*)(outp + (size_t)row * 2048 + c) = o; }
  }
}
__device__ __forceinline__ void phase_finalnorm(float* Y, const float* normw) {
  const int lane = threadIdx.x & 63, wave = threadIdx.x >> 6;
  for (int row = blockIdx.x * 8 + wave; row < NTOK; row += gridDim.x * 8) {
    float* xr = Y + (size_t)row * 2048;
    f32x4 v[8]; float ss = 0.f;
#pragma unroll
    for (int i = 0; i < 8; ++i) { v[i] = *(const f32x4*)(xr + i * 256 + lane * 4); ss += (v[i][0] * v[i][0] + v[i][1] * v[i][1]) + (v[i][2] * v[i][2] + v[i][3] * v[i][3]); }
    ss = wave_sum(ss);
    const float rstd = 1.0f / sqrtf(ss * (1.0f / 2048.0f) + EPS);
#pragma unroll
    for (int i = 0; i < 8; ++i) { const int c = i * 256 + lane * 4; const f32x4 w = *(const f32x4*)(normw + c); *(f32x4*)(xr + c) = v[i] * rstd * w; }
  }
}

namespace att {
constexpr int D = 128, NW = 8, QBLK = 32, KVBLK = 64;
constexpr float SCALE = 0.088388347648318440f;
constexpr float THR = 8.f;
constexpr int LDQ = 4096, LDK = 512, LDO = 4096;
constexpr size_t SHM_V = KVBLK * D * 2, SHM_K = KVBLK * D * 2, SHM_ATTN = 2 * SHM_V + 2 * SHM_K + NW * 64 * 4;
#define KSWZ(row, colB) ((row) * 256 + ((colB) ^ (((row) & 7) << 4)))
#define SBAR() __builtin_amdgcn_sched_barrier(0)
__device__ __forceinline__ int crow(int r, int hi) { return (r & 3) + 8 * (r >> 2) + 4 * hi; }
__device__ __forceinline__ void partialSM(f32x16& p0, f32x16& p1, float& m_reg, float& mn, float& alpha) {
  constexpr float C = SCALE * 1.4426950408889634f;
  float pmax = p0[0];
#pragma unroll
  for (int r = 1; r < 16; ++r) pmax = fmaxf(pmax, p0[r]);
#pragma unroll
  for (int r = 0; r < 16; ++r) pmax = fmaxf(pmax, p1[r]);
  { auto rr = __builtin_amdgcn_permlane32_swap(__float_as_uint(pmax), __float_as_uint(pmax), false, false);
    pmax = fmaxf(__uint_as_float(rr[0]), __uint_as_float(rr[1])); }
  if (__builtin_expect(__all(pmax - m_reg <= THR / SCALE), 1)) { mn = m_reg; alpha = 1.f; }
  else { mn = fmaxf(m_reg, pmax); alpha = __builtin_amdgcn_exp2f((m_reg - mn) * C); m_reg = mn; }
  float mnC = -mn * C;
#pragma unroll
  for (int r = 0; r < 16; ++r) p0[r] = fmaf(p0[r], C, mnC);
#pragma unroll
  for (int r = 0; r < 16; ++r) p1[r] = fmaf(p1[r], C, mnC);
#pragma unroll
  for (int r = 0; r < 16; ++r) p0[r] = __builtin_amdgcn_exp2f(p0[r]);
}
__device__ __forceinline__ void finishSM(f32x16& p0, f32x16& p1, float alpha, float& l_reg, bf16x8& pa0, bf16x8& pa1, bf16x8& pa2, bf16x8& pa3) {
#pragma unroll
  for (int r = 0; r < 16; ++r) p1[r] = __builtin_amdgcn_exp2f(p1[r]);
  float ps = 0;
#pragma unroll
  for (int r = 0; r < 16; ++r) ps += p0[r];
#pragma unroll
  for (int r = 0; r < 16; ++r) ps += p1[r];
  { auto rr = __builtin_amdgcn_permlane32_swap(__float_as_uint(ps), __float_as_uint(ps), false, false);
    ps = __uint_as_float(rr[0]) + __uint_as_float(rr[1]); }
  l_reg = l_reg * alpha + ps;
#define PK4(P, BASE, OUT) do { unsigned a0 = cvt_pk_bf16(P[BASE + 0], P[BASE + 1]), a1 = cvt_pk_bf16(P[BASE + 2], P[BASE + 3]);   \
    unsigned b0 = cvt_pk_bf16(P[BASE + 4], P[BASE + 5]), b1 = cvt_pk_bf16(P[BASE + 6], P[BASE + 7]);                              \
    auto r0 = __builtin_amdgcn_permlane32_swap(a0, b0, false, false); auto r1 = __builtin_amdgcn_permlane32_swap(a1, b1, false, false); \
    u32x4 w = {r0[0], r1[0], r0[1], r1[1]}; OUT = *reinterpret_cast<bf16x8*>(&w); } while (0)
  PK4(p0, 0, pa0); PK4(p0, 8, pa1); PK4(p1, 0, pa2); PK4(p1, 8, pa3);
#undef PK4
}
__device__ __forceinline__ void qkt(f32x16& p0, f32x16& p1, const bf16_t* Ks, const bf16x8* qr, int r32, int hi) {
  p0 = f32x16{}; p1 = f32x16{};
#pragma unroll
  for (int d0 = 0; d0 < 8; ++d0) { int cb = (d0 * 16 + hi * 8) * 2;
    bf16x8 b0 = *reinterpret_cast<const bf16x8*>((const char*)Ks + KSWZ(r32, cb));
    bf16x8 b1 = *reinterpret_cast<const bf16x8*>((const char*)Ks + KSWZ(32 + r32, cb));
    p0 = __builtin_amdgcn_mfma_f32_32x32x16_bf16(b0, qr[d0], p0, 0, 0, 0);
    p1 = __builtin_amdgcn_mfma_f32_32x32x16_bf16(b1, qr[d0], p1, 0, 0, 0); }
}
__device__ __forceinline__ int v_st(int k, int c) { const int kk = (k & ~0xC) | ((k & 4) << 1) | ((k & 8) >> 1); return ((kk >> 3) * 4 + (c >> 5)) * 512 + ((kk & 7) * 32 + (c & 31)) * 2; }
__device__ __forceinline__ int v_rd_base(int lane) { return ((lane & 3) << 3) | (((lane >> 2) & 3) << 6) | (((lane >> 4) & 1) << 5) | (((lane >> 5) & 1) << 8); }
constexpr int v_rd_off(int d0, int ks, int half) { return d0 * 512 + ks * 4096 + half * 2048; }
template <int OFF> __device__ __forceinline__ s16x4 tr_read(int vb) {
  s16x4 r; asm volatile("ds_read_b64_tr_b16 %0, %1 offset:%2" : "=&v"(r) : "v"(vb), "i"(OFF) : "memory"); return r;
}
template <int D0> __device__ __forceinline__ void pv_one(f32x16& od, int vb, bf16x8 pa0, bf16x8 pa1, bf16x8 pa2, bf16x8 pa3) {
  const s16x4 l0 = tr_read<v_rd_off(D0, 0, 0)>(vb), h0 = tr_read<v_rd_off(D0, 0, 1)>(vb), l1 = tr_read<v_rd_off(D0, 1, 0)>(vb), h1 = tr_read<v_rd_off(D0, 1, 1)>(vb);
  const s16x4 l2 = tr_read<v_rd_off(D0, 2, 0)>(vb), h2 = tr_read<v_rd_off(D0, 2, 1)>(vb), l3 = tr_read<v_rd_off(D0, 3, 0)>(vb), h3 = tr_read<v_rd_off(D0, 3, 1)>(vb);
  asm volatile("s_waitcnt lgkmcnt(0)" ::: "memory"); SBAR();
#define PK(L, H) (bf16x8){L[0], L[1], L[2], L[3], H[0], H[1], H[2], H[3]}
  od = __builtin_amdgcn_mfma_f32_32x32x16_bf16(pa0, PK(l0, h0), od, 0, 0, 0);
  od = __builtin_amdgcn_mfma_f32_32x32x16_bf16(pa1, PK(l1, h1), od, 0, 0, 0);
  od = __builtin_amdgcn_mfma_f32_32x32x16_bf16(pa2, PK(l2, h2), od, 0, 0, 0);
  od = __builtin_amdgcn_mfma_f32_32x32x16_bf16(pa3, PK(l3, h3), od, 0, 0, 0);
#undef PK
}
__device__ __forceinline__ void pv_d0(f32x16* o, int vb, bf16x8 pa0, bf16x8 pa1, bf16x8 pa2, bf16x8 pa3) {
  pv_one<0>(o[0], vb, pa0, pa1, pa2, pa3); pv_one<1>(o[1], vb, pa0, pa1, pa2, pa3); pv_one<2>(o[2], vb, pa0, pa1, pa2, pa3); pv_one<3>(o[3], vb, pa0, pa1, pa2, pa3);
}
__device__ __forceinline__ void attn_body(const bf16_t* __restrict__ Qb, const bf16_t* __restrict__ Kh, const bf16_t* __restrict__ Vh, bf16_t* __restrict__ Ob, int seq, char* lds) {
  int tid_ = threadIdx.x; asm volatile("" : "+v"(tid_));
  const int tid = tid_, wid = tid >> 6, lane = tid & 63, r32 = lane & 31, hi = lane >> 5;
  bf16_t* V_lds = (bf16_t*)lds; bf16_t* K_lds = (bf16_t*)(lds + 2 * SHM_V);
  float* wsl = (float*)(lds + 2 * SHM_V + 2 * SHM_K) + wid * 64; float* li_l = wsl; float* al_l = wsl + 32;
  float m_reg = -1e30f, l_reg = 0; f32x16 o[4] = {}; bf16x8 qr[8];
  const bf16_t* Qw = Qb + (long)(wid * QBLK + r32) * LDQ + hi * 8;
#pragma unroll
  for (int d0 = 0; d0 < 8; ++d0) qr[d0] = *reinterpret_cast<const bf16x8*>(Qw + d0 * 16);
  const int sr = tid >> 4, sc = (tid & 15) * 8, vst0 = v_st(sr, sc), vst1 = v_st(32 + sr, sc);
  const int vb0 = (int)(uintptr_t)V_lds + v_rd_base(lane);
  struct { bf16x8 vs0, vs1, ks0, ks1; } sr_[2];
#define SLOAD(i, k0) do { sr_[i].vs0 = *reinterpret_cast<const bf16x8*>(&Vh[(long)((k0) + sr) * LDK + sc]); sr_[i].vs1 = *reinterpret_cast<const bf16x8*>(&Vh[(long)((k0) + 32 + sr) * LDK + sc]); \
    sr_[i].ks0 = *reinterpret_cast<const bf16x8*>(&Kh[(long)((k0) + sr) * LDK + sc]); sr_[i].ks1 = *reinterpret_cast<const bf16x8*>(&Kh[(long)((k0) + 32 + sr) * LDK + sc]); } while (0)
#define SWRITE(b, i) do { *(bf16x8*)((char*)V_lds + (b) * SHM_V + vst0) = sr_[i].vs0;          \
    *(bf16x8*)((char*)V_lds + (b) * SHM_V + vst1) = sr_[i].vs1; int kc = sc * 2;               \
    *(bf16x8*)((char*)K_lds + (b) * SHM_K + KSWZ(sr, kc)) = sr_[i].ks0;                       \
    *(bf16x8*)((char*)K_lds + (b) * SHM_K + KSWZ(32 + sr, kc)) = sr_[i].ks1; } while (0)
#define SWAIT() asm volatile("s_waitcnt vmcnt(4)" ::: "memory")
#define RESC(a) do { if (__any((a) < 1.f)) { if (hi == 0) al_l[r32] = (a); asm volatile("s_waitcnt lgkmcnt(0)" ::: "memory"); \
    _Pragma("unroll") for (int d = 0; d < 4; ++d) _Pragma("unroll") for (int r = 0; r < 16; ++r) o[d][r] *= al_l[crow(r, hi)]; } } while (0)
  f32x16 pA0, pA1, pB0, pB1; float mnA, mnB, alA, alB; bf16x8 pa0, pa1, pa2, pa3; const int NT = seq / KVBLK;
  constexpr int SE = 0, SO = 1;
  SLOAD(SE, 0); asm volatile("s_waitcnt vmcnt(0)" ::: "memory"); SWRITE(0, SE); __syncthreads();
  qkt(pA0, pA1, K_lds, qr, r32, hi); partialSM(pA0, pA1, m_reg, mnA, alA);
  SLOAD(SO, KVBLK); if (2 < NT) SLOAD(SE, 2 * KVBLK);
  SWAIT(); SWRITE(1, SO); __syncthreads();
  for (int j = 1; j + 1 < NT; j += 2) {
    SBAR(); qkt(pB0, pB1, (bf16_t*)((char*)K_lds + SHM_K), qr, r32, hi);
    finishSM(pA0, pA1, alA, l_reg, pa0, pa1, pa2, pa3); SBAR();
    SLOAD(SO, (j + 2) * KVBLK); SBAR();
    pv_d0(o, vb0, pa0, pa1, pa2, pa3); partialSM(pB0, pB1, m_reg, mnB, alB);
    __syncthreads(); SWAIT(); SWRITE(0, SE);
    RESC(alB); __syncthreads();
    SBAR(); qkt(pA0, pA1, K_lds, qr, r32, hi);
    finishSM(pB0, pB1, alB, l_reg, pa0, pa1, pa2, pa3); SBAR();
    if (j + 3 < NT) SLOAD(SE, (j + 3) * KVBLK); SBAR();
    pv_d0(o, vb0 + (int)SHM_V, pa0, pa1, pa2, pa3); partialSM(pA0, pA1, m_reg, mnA, alA);
    __syncthreads(); SWAIT(); SWRITE(1, SO);
    RESC(alA); __syncthreads();
  }
  SBAR(); qkt(pB0, pB1, (bf16_t*)((char*)K_lds + SHM_K), qr, r32, hi);
  finishSM(pA0, pA1, alA, l_reg, pa0, pa1, pa2, pa3); SBAR();
  pv_d0(o, vb0, pa0, pa1, pa2, pa3); partialSM(pB0, pB1, m_reg, mnB, alB);
  __syncthreads(); RESC(alB);
  finishSM(pB0, pB1, alB, l_reg, pa0, pa1, pa2, pa3); SBAR();
  pv_d0(o, vb0 + (int)SHM_V, pa0, pa1, pa2, pa3);
  if (hi == 0) li_l[r32] = l_reg; asm volatile("s_waitcnt lgkmcnt(0)" ::: "memory");
  float rli[16];
#pragma unroll
  for (int r = 0; r < 16; ++r) rli[r] = __builtin_amdgcn_rcpf(li_l[crow(r, hi)]);
  bf16_t* Ow = Ob + (long)(wid * QBLK) * LDO;
#pragma unroll
  for (int r = 0; r < 16; ++r) { int orow = crow(r, hi);
#pragma unroll
    for (int d0 = 0; d0 < 4; ++d0) Ow[(long)orow * LDO + d0 * 32 + r32] = f2bf(o[d0][r] * rli[r]); }
#undef SLOAD
#undef SWRITE
#undef SWAIT
#undef RESC
}
}

constexpr int RP = 272;
__device__ __forceinline__ bf16x8 tr2(LAS unsigned char* p0, LAS unsigned char* p1) {
  const s16x4 lo = __builtin_amdgcn_ds_read_tr16_b64_v4i16((LAS s16x4*)p0), hi = __builtin_amdgcn_ds_read_tr16_b64_v4i16((LAS s16x4*)p1);
  return (bf16x8){lo[0], lo[1], lo[2], lo[3], hi[0], hi[1], hi[2], hi[3]};
}
__device__ __forceinline__ void ret_state_item(const Params& P, int item, LAS unsigned char* lds) {
  int tid_ = threadIdx.x; asm volatile("" : "+v"(tid_));
  const int tid = tid_, lane = tid & 63, w = tid >> 6, l15 = lane & 15, g = lane >> 4;
  unsigned char* ws = P.ws;
  const bool heavy = item < 256; const int id = heavy ? item : item - 256;
  const int half = id & 1, dir = (id >> 1) & 1, h = (id >> 2) & 7, bb = id >> 5;
  const int nc = heavy ? 8 : 2, row0 = heavy ? NPR + bb * 1024 : bb * 256, gc0 = heavy ? 32 + bb * 8 : bb * 2;
  const float l2g = log2_sigmoid(P.in[dir ? I_DB : I_DF][h]);
  const float G128 = __builtin_amdgcn_exp2f(128.0f * l2g);
  const bf16_t* rqk = (const bf16_t*)(ws + WS_RQK); const bf16_t* rv = (const bf16_t*)(ws + WS_RV); bf16_t* sp = (bf16_t*)(ws + WS_SP);
  const int r0 = tid >> 4, ch = tid & 15;
  const bf16_t* kg = rqk + (size_t)(row0 + r0) * 2048 + 1024 + h * 128 + ch * 8;
  const bf16_t* vg = rv + (size_t)(row0 + r0) * 2048 + h * 256 + half * 128 + ch * 8;
  u32x4 kq[4], vq[4];
  { const int c = dir ? nc - 1 : 0;
#pragma unroll
    for (int it = 0; it < 4; ++it) { kq[it] = *(const u32x4*)(kg + (size_t)(c * 128 + it * 32) * 2048); vq[it] = *(const u32x4*)(vg + (size_t)(c * 128 + it * 32) * 2048); } }
  f32x4 acc[8];
  if (heavy) { const float* s0 = P.in[dir ? I_SB : I_SF] + ((size_t)(bb * 8 + h) * 128) * 256;
#pragma unroll
    for (int nb = 0; nb < 8; ++nb)
#pragma unroll
      for (int jj = 0; jj < 4; ++jj) acc[nb][jj] = s0[(size_t)(16 * w + 4 * g + jj) * 256 + half * 128 + 16 * nb + l15]; }
  else {
#pragma unroll
    for (int nb = 0; nb < 8; ++nb) acc[nb] = (f32x4){0.f, 0.f, 0.f, 0.f}; }
  const int q4 = l15 >> 2, p4 = lane & 3;
  __syncthreads();
  float zr[4];
#pragma unroll
  for (int it = 0; it < 4; ++it) { const int r = r0 + 32 * it; zr[it] = __builtin_amdgcn_exp2f((float)(dir ? r : 127 - r) * l2g) * 0.088388347648318440f; }
  for (int step = 0; step < nc; ++step) {
    const int c = dir ? nc - 1 - step : step, gc = gc0 + c;
    LAS unsigned char* Kimg = lds + (step & 1) * (256 * RP); LAS unsigned char* Vimg = Kimg + 128 * RP;
    LAS unsigned char* ka = Kimg + (8 * g + q4) * RP + (16 * w + 4 * p4) * 2;
    LAS unsigned char* va = Vimg + (8 * g + q4) * RP + (4 * p4) * 2;
#pragma unroll
    for (int it = 0; it < 4; ++it) { const int r = r0 + 32 * it; const float z = zr[it]; const u32x4 kv = kq[it];
      u32x4 ks; ks.x = cvt_pk_bf16(bf_lo(kv.x) * z, bf_hi(kv.x) * z); ks.y = cvt_pk_bf16(bf_lo(kv.y) * z, bf_hi(kv.y) * z);
      ks.z = cvt_pk_bf16(bf_lo(kv.z) * z, bf_hi(kv.z) * z); ks.w = cvt_pk_bf16(bf_lo(kv.w) * z, bf_hi(kv.w) * z);
      *(LAS u32x4*)(Kimg + r * RP + ch * 16) = ks; *(LAS u32x4*)(Vimg + r * RP + ch * 16) = vq[it]; }
    __syncthreads();
    if (step + 1 < nc) { const int cn = dir ? nc - 2 - step : step + 1;
#pragma unroll
      for (int it = 0; it < 4; ++it) { kq[it] = *(const u32x4*)(kg + (size_t)(cn * 128 + it * 32) * 2048); vq[it] = *(const u32x4*)(vg + (size_t)(cn * 128 + it * 32) * 2048); } }
    { bf16_t* spb = sp + ((size_t)(gc * 8 + h) * 2 + dir) * 32768;
#pragma unroll
      for (int nb = 0; nb < 8; ++nb) { const int dv = half * 128 + 16 * nb + l15;
        u32x2 wv; wv.x = cvt_pk_bf16(acc[nb][0], acc[nb][1]); wv.y = cvt_pk_bf16(acc[nb][2], acc[nb][3]);
        *(u32x2*)(spb + (size_t)dv * 128 + 16 * w + 4 * g) = wv; } }
#pragma unroll
    for (int nb = 0; nb < 8; ++nb) acc[nb] *= G128;
    { bf16x8 fa[2], fb[2][8];
      fa[0] = tr2(ka, ka + 4 * RP);
#pragma unroll
      for (int nb = 0; nb < 8; ++nb) fb[0][nb] = tr2(va + nb * 32, va + 4 * RP + nb * 32);
#pragma unroll
      for (int ks = 0; ks < 4; ++ks) {
        if (ks < 3) { fa[(ks + 1) & 1] = tr2(ka + (ks + 1) * 32 * RP, ka + (ks + 1) * 32 * RP + 4 * RP);
#pragma unroll
          for (int nb = 0; nb < 8; ++nb) fb[(ks + 1) & 1][nb] = tr2(va + (ks + 1) * 32 * RP + nb * 32, va + (ks + 1) * 32 * RP + 4 * RP + nb * 32); }
        __builtin_amdgcn_sched_barrier(0);
#pragma unroll
        for (int nb = 0; nb < 8; ++nb) acc[nb] = __builtin_amdgcn_mfma_f32_16x16x32_bf16(fa[ks & 1], fb[ks & 1][nb], acc[nb], 0, 0, 0);
        __builtin_amdgcn_sched_barrier(0);
      } }
  }
  if (!heavy) { float* o = P.out + (dir ? OUT_RB : OUT_RF) + ((size_t)(bb * 8 + h) * 128) * 256;
#pragma unroll
    for (int nb = 0; nb < 8; ++nb)
#pragma unroll
      for (int jj = 0; jj < 4; ++jj) o[(size_t)(16 * w + 4 * g + jj) * 256 + half * 128 + 16 * nb + l15] = acc[nb][jj]; }
}

constexpr int R2_Q = 0, R2_P = 34816, R2_V = 69632, R2_VP = 528, R2_ST = 139264;
__device__ __forceinline__ void ret_out_item(const Params& P, int item, LAS unsigned char* lds, bf16_t* ocat_out) {
  int tid_ = threadIdx.x; asm volatile("" : "+v"(tid_));
  const int tid = tid_, lane = tid & 63, w = tid >> 6, l15 = lane & 15, g = lane >> 4;
  unsigned char* ws = P.ws;
  const int h = item & 7, gc = item >> 3; const size_t row0 = (size_t)gc * 128;
  const float l2gf = log2_sigmoid(P.in[I_DF][h]), l2gb = log2_sigmoid(P.in[I_DB][h]);
  const bf16_t* rqk = (const bf16_t*)(ws + WS_RQK); const bf16_t* rv = (const bf16_t*)(ws + WS_RV); const bf16_t* sp = (const bf16_t*)(ws + WS_SP);
  const bf16_t* ocat = (const bf16_t*)(ws + WS_OCAT);
  LAS unsigned char* Qi = lds + R2_Q; LAS unsigned char* Pl = lds + R2_P; LAS unsigned char* Vi = lds + R2_V;
  { u32x4 qv[4], vv[8];
#pragma unroll
    for (int it = 0; it < 4; ++it) { const int chid = tid + 512 * it, r = chid >> 4, ch = chid & 15; qv[it] = *(const u32x4*)(rqk + (row0 + r) * 2048 + h * 128 + ch * 8); }
#pragma unroll
    for (int it = 0; it < 8; ++it) { const int chid = tid + 512 * it, r = chid >> 5, ch = chid & 31; vv[it] = *(const u32x4*)(rv + (row0 + r) * 2048 + h * 256 + ch * 8); }
#pragma unroll
    for (int it = 0; it < 4; ++it) { const int chid = tid + 512 * it, r = chid >> 4, ch = chid & 15; *(LAS u32x4*)(Qi + r * RP + ch * 16) = qv[it]; }
#pragma unroll
    for (int it = 0; it < 8; ++it) { const int chid = tid + 512 * it, r = chid >> 5, ch = chid & 31; *(LAS u32x4*)(Vi + r * R2_VP + ch * 16) = vv[it]; } }
  bf16x8 kf[4], sf[2][4], sb[2][4];
  { const bf16_t* kp = rqk + (row0 + 16 * w + l15) * 2048 + 1024 + h * 128 + 8 * g;
#pragma unroll
    for (int ks = 0; ks < 4; ++ks) kf[ks] = *(const bf16x8*)(kp + 32 * ks);
    const bf16_t* sfp = sp + ((size_t)(gc * 8 + h) * 2) * 32768 + (size_t)(32 * w + l15) * 128 + 8 * g;
#pragma unroll
    for (int rb = 0; rb < 2; ++rb)
#pragma unroll
      for (int ks = 0; ks < 4; ++ks) { sf[rb][ks] = *(const bf16x8*)(sfp + rb * 16 * 128 + 32 * ks); sb[rb][ks] = *(const bf16x8*)(sfp + 32768 + rb * 16 * 128 + 32 * ks); } }
  __syncthreads();
  LAS unsigned char* qa = Qi + l15 * RP + (8 * g) * 2;
  f32x4 sT[8];
  { bf16x8 qb[2][4];
#pragma unroll
    for (int ks = 0; ks < 4; ++ks) qb[0][ks] = *(const LAS bf16x8*)(qa + ks * 64);
#pragma unroll
    for (int ib = 0; ib < 8; ++ib) {
      if (ib < 7) {
#pragma unroll
        for (int ks = 0; ks < 4; ++ks) qb[(ib + 1) & 1][ks] = *(const LAS bf16x8*)(qa + (ib + 1) * 16 * RP + ks * 64); }
      __builtin_amdgcn_sched_barrier(0);
      f32x4 t = (f32x4){0.f, 0.f, 0.f, 0.f};
#pragma unroll
      for (int ks = 0; ks < 4; ++ks) t = __builtin_amdgcn_mfma_f32_16x16x32_bf16(kf[ks], qb[ib & 1][ks], t, 0, 0, 0);
      sT[ib] = t;
      __builtin_amdgcn_sched_barrier(0);
    } }
#pragma unroll
  for (int ib = 0; ib < 8; ++ib) { const int i = 16 * ib + l15; float pv[4];
#pragma unroll
    for (int jj = 0; jj < 4; ++jj) { const int j = 16 * w + 4 * g + jj, d = i - j;
      const float mf = d >= 0 ? __builtin_amdgcn_exp2f((float)d * l2gf) : 0.f, mb = d <= 0 ? __builtin_amdgcn_exp2f((float)(-d) * l2gb) : 0.f;
      pv[jj] = sT[ib][jj] * (mf + mb) * 0.088388347648318440f; }
    u32x2 wv; wv.x = cvt_pk_bf16(pv[0], pv[1]); wv.y = cvt_pk_bf16(pv[2], pv[3]);
    *(LAS u32x2*)(Pl + ((ib * 4 + (w >> 1)) * 64 + lane) * 16 + (w & 1) * 8) = wv; }
  __syncthreads();
  f32x4 o[2][8];
  { bf16x8 qb[2][4];
#pragma unroll
    for (int ks = 0; ks < 4; ++ks) qb[0][ks] = *(const LAS bf16x8*)(qa + ks * 64);
#pragma unroll
    for (int ib = 0; ib < 8; ++ib) { int i = 16 * ib + l15; asm volatile("" : "+v"(i));
      if (ib < 7) {
#pragma unroll
        for (int ks = 0; ks < 4; ++ks) qb[(ib + 1) & 1][ks] = *(const LAS bf16x8*)(qa + (ib + 1) * 16 * RP + ks * 64); }
      const float sc1 = __builtin_amdgcn_exp2f((float)(i + 1) * l2gf - (float)(128 - i) * l2gb);
      const float sc2 = __builtin_amdgcn_exp2f((float)(128 - i) * l2gb);
      __builtin_amdgcn_sched_barrier(0);
      f32x4 a0 = (f32x4){0.f, 0.f, 0.f, 0.f}, a1 = (f32x4){0.f, 0.f, 0.f, 0.f};
#pragma unroll
      for (int ks = 0; ks < 4; ++ks) { a0 = __builtin_amdgcn_mfma_f32_16x16x32_bf16(sf[0][ks], qb[ib & 1][ks], a0, 0, 0, 0); a1 = __builtin_amdgcn_mfma_f32_16x16x32_bf16(sf[1][ks], qb[ib & 1][ks], a1, 0, 0, 0); }
      a0 *= sc1; a1 *= sc1;
#pragma unroll
      for (int ks = 0; ks < 4; ++ks) { a0 = __builtin_amdgcn_mfma_f32_16x16x32_bf16(sb[0][ks], qb[ib & 1][ks], a0, 0, 0, 0); a1 = __builtin_amdgcn_mfma_f32_16x16x32_bf16(sb[1][ks], qb[ib & 1][ks], a1, 0, 0, 0); }
      o[0][ib] = a0 * sc2; o[1][ib] = a1 * sc2;
      __builtin_amdgcn_sched_barrier(0);
    } }
  u32x2 rg[2][8];
#pragma unroll
  for (int ib = 0; ib < 8; ++ib)
#pragma unroll
    for (int rb = 0; rb < 2; ++rb) rg[rb][ib] = *(const u32x2*)(ocat + (row0 + 16 * ib + l15) * 4096 + 2048 + h * 256 + 32 * w + 4 * g + rb * 16);
  { const int q4 = l15 >> 2, p4 = lane & 3;
    LAS unsigned char* va = Vi + (4 * g + q4) * R2_VP + (32 * w + 4 * p4) * 2;
    bf16x8 vf[2][4];
#pragma unroll
    for (int rb = 0; rb < 2; ++rb)
#pragma unroll
      for (int kb = 0; kb < 4; ++kb) vf[rb][kb] = tr2(va + kb * 32 * R2_VP + rb * 32, va + kb * 32 * R2_VP + 16 * R2_VP + rb * 32);
    bf16x8 pq[2][4];
#pragma unroll
    for (int kb = 0; kb < 4; ++kb) pq[0][kb] = *(const LAS bf16x8*)(Pl + (kb * 64 + lane) * 16);
#pragma unroll
    for (int ib = 0; ib < 8; ++ib) {
      if (ib < 7) {
#pragma unroll
        for (int kb = 0; kb < 4; ++kb) pq[(ib + 1) & 1][kb] = *(const LAS bf16x8*)(Pl + (((ib + 1) * 4 + kb) * 64 + lane) * 16); }
      __builtin_amdgcn_sched_barrier(0);
#pragma unroll
      for (int kb = 0; kb < 4; ++kb) {
        o[0][ib] = __builtin_amdgcn_mfma_f32_16x16x32_bf16(vf[0][kb], pq[ib & 1][kb], o[0][ib], 0, 0, 0);
        o[1][ib] = __builtin_amdgcn_mfma_f32_16x16x32_bf16(vf[1][kb], pq[ib & 1][kb], o[1][ib], 0, 0, 0); }
      __builtin_amdgcn_sched_barrier(0);
    } }
  LAS float* St = (LAS float*)(lds + R2_ST);
#pragma unroll
  for (int ib = 0; ib < 8; ++ib) { const f32x4 a = o[0][ib], b = o[1][ib];
    float s1 = (a[0] + a[1]) + (a[2] + a[3]) + (b[0] + b[1]) + (b[2] + b[3]);
    float s2 = (a[0] * a[0] + a[1] * a[1]) + (a[2] * a[2] + a[3] * a[3]) + (b[0] * b[0] + b[1] * b[1]) + (b[2] * b[2] + b[3] * b[3]);
    s1 += __shfl_xor(s1, 16); s1 += __shfl_xor(s1, 32); s2 += __shfl_xor(s2, 16); s2 += __shfl_xor(s2, 32);
    if (g == 0) { St[(w * 128 + 16 * ib + l15) * 2] = s1; St[(w * 128 + 16 * ib + l15) * 2 + 1] = s2; } }
  __syncthreads();
  const float* rn = P.in[I_RN] + h * 256 + 32 * w + 4 * g;
  const f32x4 wn0 = *(const f32x4*)rn, wn1 = *(const f32x4*)(rn + 16);
#pragma unroll
  for (int ib = 0; ib < 8; ++ib) { int i = 16 * ib + l15; asm volatile("" : "+v"(i)); float s1 = 0.f, s2 = 0.f;
#pragma unroll
    for (int ww = 0; ww < 8; ++ww) { s1 += St[(ww * 128 + i) * 2]; s2 += St[(ww * 128 + i) * 2 + 1]; }
    const float mu = s1 * (1.0f / 256.0f); const float var = fmaxf(s2 * (1.0f / 256.0f) - mu * mu, 0.f);
    const float rstd = 1.0f / sqrtf(var + EPS);
    const size_t ro = (row0 + i) * 4096 + 2048 + h * 256 + 32 * w + 4 * g;
#pragma unroll
    for (int rb = 0; rb < 2; ++rb) { const u32x2 gg = rg[rb][ib];
      const f32x4 y = (o[rb][ib] - mu) * rstd * (rb ? wn1 : wn0);
      u32x2 wv; wv.x = cvt_pk_bf16(y[0] * bf_lo(gg.x), y[1] * bf_hi(gg.x)); wv.y = cvt_pk_bf16(y[2] * bf_lo(gg.y), y[3] * bf_hi(gg.y));
      *(u32x2*)(ocat_out + ro + rb * 16) = wv; }
    asm volatile("" ::: "memory"); }
}


#define XB_TMO      128
#define XB_XCNT(j)  (256  + 64 * (j))
#define XB_XSUB(j)  (1280 + 64 * (j))
#define XB_XGEN(j)  (2304 + 64 * (j))
#define XB_TOP      3328
#define XB_TOPGEN   3392
#define XCD_BAR_WORDS 3456
#define XB_SPIN_CAP (1u << 18)
__device__ __forceinline__ unsigned xb_ld(unsigned* p)              { return __hip_atomic_load(p, __ATOMIC_RELAXED, __HIP_MEMORY_SCOPE_AGENT); }
__device__ __forceinline__ unsigned xb_add(unsigned* p, unsigned v) { return __hip_atomic_fetch_add(p, v, __ATOMIC_RELAXED, __HIP_MEMORY_SCOPE_AGENT); }
__device__ __forceinline__ unsigned xb_xcc_id() { return (unsigned)__builtin_amdgcn_s_getreg((3 << 11) | 20) & 0xFu; }
#define XB_SPIN(cond, bar) do { unsigned _sp = 0; while (cond) { __builtin_amdgcn_s_sleep(1); \
    if ((++_sp & 255u) == 0u) { if (xb_ld(&(bar)[XB_TMO])) break; if (_sp > XB_SPIN_CAP) { atomicAdd(&(bar)[XB_TMO], 1u); break; } } } } while (0)
struct XcdBarrier { unsigned* bar; unsigned x; volatile LAS unsigned* st; };
__device__ __forceinline__ XcdBarrier xcd_barrier_post(unsigned* bar, volatile LAS unsigned* st) {
  XcdBarrier b; b.bar = bar; b.x = xb_xcc_id(); b.st = st;
  if (threadIdx.x == 0) (void)xb_add(&bar[XB_XCNT(b.x)], 1u);
  return b;
}
__device__ __forceinline__ void xcd_barrier_complete(unsigned* bar, unsigned x, unsigned& nloc, unsigned& nx) {
  const unsigned G = gridDim.x * gridDim.y * gridDim.z;
  unsigned sum, cnt, mine, sp = 0u;
  for (;;) {
    sum = 0u; cnt = 0u; mine = 0u;
#pragma unroll
    for (unsigned j = 0; j < 16; ++j) { const unsigned c = xb_ld(&bar[XB_XCNT(j)]); sum += c; cnt += (c > 0u) ? 1u : 0u; mine = (j == x) ? c : mine; }
    if (sum == G) break;
    __builtin_amdgcn_s_sleep(1);
    if ((++sp & 255u) == 0u) { if (xb_ld(&bar[XB_TMO])) break; if (sp > XB_SPIN_CAP) { atomicAdd(&bar[XB_TMO], 1u); break; } }
  }
  nloc = mine > 0u ? mine : 1u; nx = cnt > 0u ? cnt : 1u;
}
__device__ __forceinline__ void xcd_barrier(const XcdBarrier& b) {
  asm volatile("s_waitcnt vmcnt(0)" ::: "memory");
  __syncthreads();
  if (threadIdx.x == 0) {
    unsigned* bar = b.bar;
    __builtin_amdgcn_s_waitcnt(0);
    unsigned nloc = b.st[0], nx = b.st[1];
    if (nloc == 0u) { xcd_barrier_complete(bar, b.x, nloc, nx); b.st[0] = nloc; b.st[1] = nx; }
    const unsigned old = xb_add(&bar[XB_XSUB(b.x)], 1u);
    const unsigned gen = old / nloc;
    if (old + 1u == (gen + 1u) * nloc) {
      __builtin_amdgcn_fence(__ATOMIC_RELEASE, "agent");
      asm volatile("s_waitcnt vmcnt(0)" ::: "memory");
      const unsigned og = xb_add(&bar[XB_TOP], 1u);
      const unsigned tg = og / nx;
      if (og + 1u == (tg + 1u) * nx) xb_add(&bar[XB_TOPGEN], 1u);
      else XB_SPIN(xb_ld(&bar[XB_TOPGEN]) == tg, bar);
      __builtin_amdgcn_fence(__ATOMIC_ACQUIRE, "agent");
      xb_add(&bar[XB_XGEN(b.x)], 1u);
      asm volatile("s_waitcnt vmcnt(0)" ::: "memory");
    } else {
      XB_SPIN(xb_ld(&bar[XB_XGEN(b.x)]) == gen, bar);
      __builtin_amdgcn_fence(__ATOMIC_ACQUIRE, "agent");
      asm volatile("s_waitcnt vmcnt(0)" ::: "memory");
    }
  }
  __syncthreads();
}

__global__ void __launch_bounds__(NTHREADS, 2) mk_fwd(Params P) {
  extern __shared__ __attribute__((aligned(16))) unsigned char lds_raw[];
  LAS unsigned char* lds = (LAS unsigned char*)lds_raw;
  cg::grid_group grid = cg::this_grid();
  unsigned char* ws = P.ws;
  const int G = gridDim.x, bid = blockIdx.x;
  const int lo = P.ph_lo, hi = P.ph_hi;
#ifndef PHMASK
#define PHMASK 0x7ff
#endif
#define IN(k) (((PHMASK >> (k)) & 1) && lo <= (k) && (k) < hi)
#define GSYNC() xcd_barrier(xbar)
#define SEAM(k) do { if (P.coop && IN(k) && IN((k) + 1)) GSYNC(); } while (0)
  if (threadIdx.x < 4) ((volatile LAS unsigned*)(lds + LDS_ST_OFF))[threadIdx.x] = 0u;
  __syncthreads();
  XcdBarrier xbar; xbar.bar = (unsigned*)(ws + WS_BAR); xbar.x = 0; xbar.st = (volatile LAS unsigned*)(lds + LDS_ST_OFF);
  if (P.coop) xbar = xcd_barrier_post((unsigned*)(ws + WS_BAR), (volatile LAS unsigned*)(lds + LDS_ST_OFF));
  if (P.coop == 2) grid.sync();
  float* modv = (float*)(ws + WS_MODV);
  float* Y = P.out + OUT_Y;

  if (PROBE_PH == 99) { for (int r = 0; r < 10; ++r) GSYNC(); }
  unsigned* p0cnt = (unsigned*)(ws + WS_BAR) + 3584;
  if (IN(0)) {
    phase_prep_gemv(P, lds, modv);
    asm volatile("s_waitcnt vmcnt(0)" ::: "memory");
    __syncthreads();
    if (threadIdx.x == 0) __hip_atomic_fetch_add(p0cnt, 1u, __ATOMIC_RELAXED, __HIP_MEMORY_SCOPE_AGENT);
    phase_prep_rest(P, lds);
  }
  if (IN(1)) {
    if (P.coop && IN(0)) {
      if (threadIdx.x == 0) { unsigned sp = 0;
        while (__hip_atomic_load(p0cnt, __ATOMIC_RELAXED, __HIP_MEMORY_SCOPE_AGENT) < (unsigned)G) { __builtin_amdgcn_s_sleep(2); if (++sp > (1u << 20)) break; }
        __builtin_amdgcn_fence(__ATOMIC_ACQUIRE, "agent");
        asm volatile("s_waitcnt vmcnt(0)" ::: "memory"); }
      __syncthreads();
    }
    phase_modnorm(P.in[I_XP], P.in[I_XS], P.in[I_NA], modv, 0, 1, (bf16_t*)(ws + WS_H));
  }
  SEAM(1);
  if (IN(2)) { for (int rep = 0; rep < REP(2); ++rep) {
    pg8::Gemm g{(const bf16_t*)(ws + WS_H), (const bf16_t*)(ws + WS_WTIN), NTOK, NIN, DM, DM, DM}; pg8::StaticOrder S; S.init(NTOK, NIN, G, bid);
    EpiIn E{ws, P.out, P.in[I_QN], P.in[I_KN], (LAS float*)(lds + LDS_X_OFF)};
    pg8::gemm_phase<EpiIn>(lds, g, S, E);
    if (rep + 1 < REP(2)) GSYNC(); }
    { CvtJob J5{P.in[I_WG], P.in[I_WU], DFF, (bf16_t*)(ws + WS_WTGU), 2048, 0, 16, 2};
      const bool tailwg = (G == 256); const int c0 = tailwg ? bid - 192 : bid, cs = tailwg ? 64 : G;
      if (c0 >= 0) cvt_tiles(J5, c0, (tailwg ? 64 * 16 : 88 * 16), cs, lds); }
  }
  SEAM(2);
#define ATTN_HEAVY(itx) do { const int it_ = (itx); const int qb = it_ & 3, h = (it_ >> 2) & 15, bs = it_ >> 6; \
    const size_t q0 = ((size_t)(NPR + bs * 1024 + qb * 256)) * 4096 + h * 128, k0 = ((size_t)bs * 1536) * 512 + (h >> 2) * 128; \
    att::attn_body((const bf16_t*)(ws + WS_OCAT) + q0, (const bf16_t*)(ws + WS_KALL) + k0, (const bf16_t*)(ws + WS_VALL) + k0, (bf16_t*)(ws + WS_OCAT) + q0, 1536, (char*)lds_raw); __syncthreads(); } while (0)
  if (IN(3)) {
    const bool attn_first = ((bid >> 3) & 1) != 0;
#pragma clang loop unroll(disable)
    for (int pass = 0; pass < 2; ++pass) {
      if ((pass == 0) == attn_first) {
#pragma clang loop unroll(disable)
        for (int it = bid; it < 256; it += G) ATTN_HEAVY(it);
#pragma clang loop unroll(disable)
        for (int id = bid; id < 256; id += G) { const int h = id & 15, b = id >> 4;
          const size_t q0 = ((size_t)(b * 256)) * 4096 + h * 128, k0 = ((size_t)b * 256) * 512 + (h >> 2) * 128;
          att::attn_body((const bf16_t*)(ws + WS_OCAT) + q0, (const bf16_t*)(ws + WS_KP) + k0, (const bf16_t*)(ws + WS_VP) + k0, (bf16_t*)(ws + WS_OCAT) + q0, 256, (char*)lds_raw);
          __syncthreads(); }
      } else {
#pragma clang loop unroll(disable)
        for (int it = bid; it < 768; it += G) ret_state_item(P, it, lds);
        __syncthreads();
      }
    }
  }
  SEAM(3);
  if (IN(4)) {
    const bool attn_first = ((bid >> 3) & 1) != 0;
#pragma clang loop unroll(disable)
    for (int pass = 0; pass < 2; ++pass) {
      if ((pass == 0) == attn_first) {
#pragma clang loop unroll(disable)
        for (int it = 256 + bid; it < 512; it += G) ATTN_HEAVY(it);
      } else {
        if (G == 256) { CvtJob J5{P.in[I_WG], P.in[I_WU], DFF, (bf16_t*)(ws + WS_WTGU), 2048, 0, 16, 2};
          cvt_tiles(J5, 64 * 16 + bid, 88 * 16, G, lds); }
#pragma clang loop unroll(disable)
        for (int it = bid; it < 768; it += G) ret_out_item(P, it, lds, (bf16_t*)(ws + WS_OCAT));
        __syncthreads();
      }
    }
  }
#undef ATTN_HEAVY
  SEAM(4);
  if (IN(5)) {
    for (int rep = 0; rep < REP(5); ++rep) {
    pg8::Gemm g{(const bf16_t*)(ws + WS_OCAT), (const bf16_t*)(ws + WS_WTCAT), NTOK, DM, 2048, 4096, 4096}; pg8::StaticOrder S; S.init(NTOK, DM, G, bid, 192);
    EpiMerge<3> E{(const bf16_t*)(ws + WS_SGA), (const bf16_t*)(ws + WS_SGR), (bf16_t*)(ws + WS_RV)};
    pg8::gemm_phase<EpiMerge<3>, 3>(lds, g, S, E);
    if (rep + 1 < REP(5)) GSYNC(); }
  }
  SEAM(5);
  if (IN(6)) {
    pg8::Gemm g{(const bf16_t*)(ws + WS_RV), (const bf16_t*)(ws + WS_WTOUT), NTOK, DM, DM, DM, DM}; PanelOrder S; S.init(bid);
    EpiResNorm<0> E{P.in[I_XP], P.in[I_XS], Y, modv, 2, P.in[I_NF], (bf16_t*)(ws + WS_RQK), (float*)(ws + WS_SLOT6), (unsigned*)(ws + WS_CNT6), (LAS float*)(lds + LDS_X_OFF)};
    pg8::gemm_phase<EpiResNorm<0>, 3, PanelOrder>(lds, g, S, E);
  }
  if (P.coop && IN(6) && IN(8)) GSYNC();
  if (IN(8)) {
    pg8::Gemm g{(const bf16_t*)(ws + WS_RQK), (const bf16_t*)(ws + WS_WTGU), NTOK, 2 * DFF, DM, DM, DM}; pg8::StaticOrder S; S.init(NTOK, 2 * DFF, G, bid);
    if (G == 256) {
      S.imax = 8;
      { EpiGU<4> E{(bf16_t*)(ws + WS_ACT)}; pg8::gemm_phase<EpiGU<4>>(lds, g, S, E); }
      TailOrder T; T.S = S; T.L0 = 2048; T.ntail = 64; T.c = bid;
      { EpiGU<1> E{(bf16_t*)(ws + WS_ACT)}; pg8::gemm_phase<EpiGU<1>, 1, TailOrder>(lds, g, T, E); }
    } else { EpiGU<4> E{(bf16_t*)(ws + WS_ACT)}; pg8::gemm_phase<EpiGU<4>>(lds, g, S, E); }
    { CvtJob J6{P.in[I_WD], nullptr, 2048, (bf16_t*)(ws + WS_WTD), DFF, 0, 44, 0};
      cvt_tiles(J6, bid, 16 * 44, G, lds); }
  }
  SEAM(8);
  if (IN(9)) {
    pg8::Gemm g{(const bf16_t*)(ws + WS_ACT), (const bf16_t*)(ws + WS_WTD), NTOK, DM, DFF, DFF, DFF}; PanelOrder S; S.init(bid);
    EpiResNorm<1> E{Y, Y + (size_t)NPR * 2048, Y, modv, 5, P.in[I_FN], nullptr, (float*)(ws + WS_SLOT9), (unsigned*)(ws + WS_CNT9), (LAS float*)(lds + LDS_X_OFF)};
    pg8::gemm_phase<EpiResNorm<1>, 3, PanelOrder>(lds, g, S, E);
  }
#undef IN
#undef SEAM
#undef GSYNC
}

extern "C" void kernel_launch(void* const* d_in, const int* in_sizes, int n_in, void* d_out, int out_size, void* d_ws, size_t ws_size, hipStream_t stream) {
  static int grid = 0;
  if (grid == 0) {
    if (n_in != 25 || ws_size < WS_END) { fprintf(stderr, "kernel_launch: n_in %d ws %zu (need %zu)\n", n_in, ws_size, (size_t)WS_END); grid = -1; return; }
    if (hipFuncSetAttribute((const void*)mk_fwd, hipFuncAttributeMaxDynamicSharedMemorySize, LDS_BYTES) != hipSuccess) { fprintf(stderr, "kernel_launch: hipFuncSetAttribute failed\n"); grid = -1; return; }
    int dev = 0, cus = 0, per_cu = 0;
    hipGetDevice(&dev); hipDeviceGetAttribute(&cus, hipDeviceAttributeMultiprocessorCount, dev);
    if (hipOccupancyMaxActiveBlocksPerMultiprocessor(&per_cu, (const void*)mk_fwd, NTHREADS, LDS_BYTES) != hipSuccess || per_cu < 1) { fprintf(stderr, "kernel_launch: occupancy query gave %d\n", per_cu); per_cu = 1; }
    (void)hipGetLastError();
    grid = cus;
    if (cus != 256) { fprintf(stderr, "kernel_launch: built for 256 CUs, got %d\n", cus); grid = -1; return; }
  }
  if (grid < 0) return;
  (void)hipMemsetAsync((char*)d_ws + WS_MODV, 0, WS_SLOT6 - WS_MODV, stream);
  Params p{};
  for (int i = 0; i < 25; ++i) p.in[i] = (const float*)d_in[i];
  p.out = (float*)d_out; p.ws = (unsigned char*)d_ws;
#if MK_MULTI
  for (int ph = 0; ph <= 10; ++ph) { p.ph_lo = ph; p.ph_hi = ph + 1; p.coop = 0;
    hipLaunchKernelGGL(mk_fwd, dim3(grid), dim3(NTHREADS), LDS_BYTES, stream, p); }
#else
  p.ph_lo = 0; p.ph_hi = 11; p.coop = 1;
  void* args[] = {&p};
  hipError_t e = hipLaunchCooperativeKernel((const void*)mk_fwd, dim3(grid), dim3(NTHREADS), args, LDS_BYTES, stream);
  if (e != hipSuccess) fprintf(stderr, "kernel_launch: cooperative launch failed: %s\n", hipGetErrorString(e));
#endif
}
```
